# Optimizing an MI355X kernel written in HIP

```python
import math
import jax, jax.numpy as jnp
from jax import lax
import numpy as np

D_MODEL = 1024
BATCH = 2
SEQ = 8192
DEPTH = 4
DEC_BATCH = 128
DEC_SEQ = 8
PAST_LEN = 8192
PAGE_SIZE = 128

N_MIXERS = 3
N_A = (DEPTH + 2) // 3
N_B = (DEPTH + 1) // 3
N_C = DEPTH // 3
NORM_EPS = 1e-6

A_HEADS = 4
A_DK = D_MODEL // 2 // A_HEADS
A_DV = D_MODEL // A_HEADS
A_CHUNK = 64
A_Q_END = A_HEADS * A_DK
A_K_END = 2 * A_Q_END
A_V_END = A_K_END + A_HEADS * A_DV
A_O_END = A_V_END + A_HEADS * A_DV
A_I_END = A_O_END + A_HEADS
A_IN = A_I_END + A_HEADS

B_HEADS = 16
B_KV_HEADS = 4
B_HD = D_MODEL // B_HEADS
B_GROUP = B_HEADS // B_KV_HEADS
B_IN = (B_HEADS + 2 * B_KV_HEADS) * B_HD
WINDOW = 128
ROPE_THETA = 500000.0
ROPE_DIM = B_HD // 4

C_WIDTH = D_MODEL
C_BLOCKS = 4
C_BW = C_WIDTH // C_BLOCKS
CONV_W = 4
LRU_C = 8.0

D_FF = 4 * D_MODEL

kernel_name = 'hybrid_mlstm_swa_rglru_step'


def rmsnorm(x, g):
    xf = x.astype(jnp.float32)
    y = xf * lax.rsqrt(jnp.mean(xf * xf, axis=-1, keepdims=True) + NORM_EPS)
    return (y * g.astype(jnp.float32)).astype(x.dtype)


def sqrelu_mlp(x, w_up, w_down):
    h = jax.nn.relu(x @ w_up)
    return (h * h) @ w_down


def mlstm_scan(q, k, v, ig, lf, c0, n0, m0):
    bsz, s = q.shape[0], q.shape[1]
    L = math.gcd(s, A_CHUNK)
    nc = s // L

    def to_chunks(t):
        return jnp.moveaxis(t.reshape((bsz, nc, L) + t.shape[2:]), 1, 0)

    causal = jnp.tril(jnp.ones((L, L), dtype=bool))

    def step(carry, inp):
        c, n, m = carry
        qb, kb, vb, ib, fb = inp
        bt = jnp.swapaxes(jnp.cumsum(fb, axis=1), 1, 2)
        it = jnp.swapaxes(ib, 1, 2)
        dmat = bt[..., :, None] - bt[..., None, :] + it[..., None, :]
        dmat = jnp.where(causal, dmat, -jnp.inf)
        inter = bt + m[..., None]
        m_t = jnp.maximum(jnp.max(dmat, axis=-1), inter)
        w = jnp.exp(dmat - m_t[..., None])
        w_inter = jnp.swapaxes(jnp.exp(inter - m_t), 1, 2)
        s_qk = jnp.einsum('bthd,bshd->bhts', qb, kb) * w
        num = jnp.einsum('bhts,bshv->bthv', s_qk, vb) + w_inter[..., None] * jnp.einsum('bhvk,bthk->bthv', c, qb)
        den = jnp.swapaxes(jnp.sum(s_qk, axis=-1), 1, 2) + w_inter * jnp.einsum('bhk,bthk->bth', n, qb)
        h = num / jnp.maximum(jnp.abs(den), jnp.exp(-jnp.swapaxes(m_t, 1, 2)))[..., None]
        m_new = m_t[..., -1]
        decay_src = jnp.exp(bt[..., -1:] - bt + it - m_new[..., None])
        carry_scale = jnp.exp(inter[..., -1] - m_new)
        c_new = carry_scale[..., None, None] * c + jnp.einsum('bhs,bshv,bshk->bhvk', decay_src, vb, kb)
        n_new = carry_scale[..., None] * n + jnp.einsum('bhs,bshk->bhk', decay_src, kb)
        return (c_new, n_new, m_new), h

    (c, n, m), hs = lax.scan(step, (c0, n0, m0), tuple(map(to_chunks, (q, k, v, ig, lf))))
    hs = jnp.moveaxis(hs, 0, 1).reshape(bsz, s, A_HEADS, A_DV)
    return hs, c, n, m


def mlstm_layer(x, c0, n0, m0, w_in, b_i, b_f, g_head, w_out):
    bsz, s, _ = x.shape
    f32 = jnp.float32
    proj = x @ w_in
    q = proj[..., :A_Q_END].reshape(bsz, s, A_HEADS, A_DK).astype(f32)
    k = proj[..., A_Q_END:A_K_END].reshape(bsz, s, A_HEADS, A_DK).astype(f32) * (A_DK ** -0.5)
    v = proj[..., A_K_END:A_V_END].reshape(bsz, s, A_HEADS, A_DV).astype(f32)
    o = jax.nn.sigmoid(proj[..., A_V_END:A_O_END].astype(f32))
    ig = (proj[..., A_O_END:A_I_END] + b_i).astype(f32)
    lf = jax.nn.log_sigmoid((proj[..., A_I_END:A_IN] + b_f).astype(f32))
    h, c, n, m = mlstm_scan(q, k, v, ig, lf, c0.astype(f32), n0.astype(f32), m0.astype(f32))
    h = h * lax.rsqrt(jnp.mean(h * h, axis=-1, keepdims=True) + NORM_EPS) * g_head.astype(f32)
    h = o * h.reshape(bsz, s, A_HEADS * A_DV)
    return h.astype(x.dtype) @ w_out, c, n, m


def rope_partial(x, pos):
    inv = ROPE_THETA ** (-jnp.arange(0, ROPE_DIM, 2, dtype=jnp.float32) / ROPE_DIM)
    ang = pos.astype(jnp.float32)[:, None] * inv[None, :]
    cos = jnp.cos(ang)[None, :, None, :]
    sin = jnp.sin(ang)[None, :, None, :]
    xr = x[..., :ROPE_DIM].astype(jnp.float32)
    x1, x2 = xr[..., :ROPE_DIM // 2], xr[..., ROPE_DIM // 2:]
    rot = jnp.concatenate([x1 * cos - x2 * sin, x2 * cos + x1 * sin], axis=-1)
    return jnp.concatenate([rot.astype(x.dtype), x[..., ROPE_DIM:]], axis=-1)


def swa_qkv(x, pos, w_qkv, b_qkv):
    bsz, s, _ = x.shape
    proj = x @ w_qkv + b_qkv
    q = rope_partial(proj[..., :B_HEADS * B_HD].reshape(bsz, s, B_HEADS, B_HD), pos)
    k = rope_partial(proj[..., B_HEADS * B_HD:(B_HEADS + B_KV_HEADS) * B_HD].reshape(bsz, s, B_KV_HEADS, B_HD), pos)
    v = proj[..., (B_HEADS + B_KV_HEADS) * B_HD:].reshape(bsz, s, B_KV_HEADS, B_HD)
    return q, k, v


def sink_attention(q, k, v, q_pos, k_pos, sinks):
    scores = jnp.einsum('bnqhgd,bnshd->bnhgqs', q, k).astype(jnp.float32) * (B_HD ** -0.5)
    diff = q_pos[:, :, None] - k_pos[:, None, :]
    allowed = (diff >= 0) & (diff < WINDOW) & (k_pos[:, None, :] >= 0)
    scores = jnp.where(allowed[None, :, None, None], scores, -jnp.inf)
    sink = jnp.broadcast_to(sinks.astype(jnp.float32).reshape(B_KV_HEADS, B_GROUP)[None, None, :, :, None, None],
                            scores.shape[:-1] + (1,))
    p = jax.nn.softmax(jnp.concatenate([scores, sink], axis=-1), axis=-1)[..., :-1]
    return jnp.einsum('bnhgqs,bnshd->bnqhgd', p.astype(v.dtype), v)


def swa_prompt(x, w_qkv, b_qkv, sinks, w_out, b_out):
    bsz, s, _ = x.shape
    pos = jnp.arange(s, dtype=jnp.int32)
    q, k, v = swa_qkv(x, pos, w_qkv, b_qkv)
    nb = s // WINDOW
    qb = q.reshape(bsz, nb, WINDOW, B_KV_HEADS, B_GROUP, B_HD)
    pad = jnp.zeros((bsz, WINDOW, B_KV_HEADS, B_HD), k.dtype)
    kp = jnp.concatenate([pad, k], axis=1).reshape(bsz, nb + 1, WINDOW, B_KV_HEADS, B_HD)
    vp = jnp.concatenate([pad, v], axis=1).reshape(bsz, nb + 1, WINDOW, B_KV_HEADS, B_HD)
    kb = jnp.concatenate([kp[:, :-1], kp[:, 1:]], axis=2)
    vb = jnp.concatenate([vp[:, :-1], vp[:, 1:]], axis=2)
    q_pos = pos.reshape(nb, WINDOW)
    k_pos = (jnp.arange(nb, dtype=jnp.int32)[:, None] - 1) * WINDOW + jnp.arange(2 * WINDOW, dtype=jnp.int32)[None, :]
    o = sink_attention(qb, kb, vb, q_pos, k_pos, sinks).reshape(bsz, s, B_HEADS * B_HD)
    buf = min(WINDOW, s)
    return o @ w_out + b_out, k[:, s - buf:], v[:, s - buf:]


def swa_sample(x, k_cache, v_cache, w_qkv, b_qkv, sinks, w_out, b_out):
    bsz, s, _ = x.shape
    pos = PAST_LEN + jnp.arange(s, dtype=jnp.int32)
    q, k, v = swa_qkv(x, pos, w_qkv, b_qkv)
    buf = k_cache.shape[1]
    kall = jnp.concatenate([k_cache.astype(k.dtype), k], axis=1)
    vall = jnp.concatenate([v_cache.astype(v.dtype), v], axis=1)
    k_pos = jnp.concatenate([PAST_LEN - buf + jnp.arange(buf, dtype=jnp.int32), pos])
    qb = q.reshape(bsz, 1, s, B_KV_HEADS, B_GROUP, B_HD)
    o = sink_attention(qb, kall[:, None], vall[:, None], pos[None], k_pos[None], sinks).reshape(bsz, s, B_HEADS * B_HD)
    return o @ w_out + b_out, kall[:, -buf:], vall[:, -buf:]


def lru_combine(left, right):
    a1, b1 = left
    a2, b2 = right
    return a1 * a2, a2 * b1 + b2


def rglru_layer(x, h0, conv0, w_in, w_conv, b_conv, w_a, b_a, w_x, b_x, lam, w_out):
    bsz, s, _ = x.shape
    f32 = jnp.float32
    proj = x @ w_in
    xb, gate = proj[..., :C_WIDTH], proj[..., C_WIDTH:]
    xp = jnp.concatenate([conv0.astype(xb.dtype), xb], axis=1)
    u = b_conv
    for j in range(CONV_W):
        u = u + w_conv[j] * xp[:, j:j + s]
    new_conv = xp[:, s:]
    ub = u.reshape(bsz, s, C_BLOCKS, C_BW)
    r = jax.nn.sigmoid((jnp.einsum('bsnc,ncd->bsnd', ub, w_a).reshape(bsz, s, C_WIDTH) + b_a).astype(f32))
    gi = jax.nn.sigmoid((jnp.einsum('bsnc,ncd->bsnd', ub, w_x).reshape(bsz, s, C_WIDTH) + b_x).astype(f32))
    log_a = -LRU_C * r * jax.nn.softplus(-lam.astype(f32))
    a = jnp.exp(log_a)
    bterm = jnp.sqrt(-jnp.expm1(2.0 * log_a)) * gi * u.astype(f32)
    acum, bcum = lax.associative_scan(lru_combine, (a, bterm), axis=1)
    h = acum * h0.astype(f32)[:, None] + bcum
    y = (h.astype(x.dtype) * jax.nn.gelu(gate)) @ w_out
    return y, h[:, -1], new_conv


def trunk(x, prompt, c_in, n_in, m_in, k_in, v_in, h_in, conv_in, p):
    bsz = x.shape[0]
    f32 = jnp.float32
    out_c, out_n, out_m, out_k, out_v, out_h, out_conv = [], [], [], [], [], [], []
    for i in range(DEPTH):
        kind = i % N_MIXERS
        j = i // N_MIXERS
        hn = rmsnorm(x, p['norm_mix'][i])
        if kind == 0:
            if prompt:
                c0 = jnp.zeros((bsz, A_HEADS, A_DV, A_DK), f32)
                n0 = jnp.zeros((bsz, A_HEADS, A_DK), f32)
                m0 = jnp.zeros((bsz, A_HEADS), f32)
            else:
                c0, n0, m0 = c_in[j], n_in[j], m_in[j]
            y, c, n, m = mlstm_layer(hn, c0, n0, m0, p['w_mlstm_in'][j], p['b_mlstm_i'][j], p['b_mlstm_f'][j],
                                     p['g_mlstm_head'][j], p['w_mlstm_out'][j])
            out_c.append(c); out_n.append(n); out_m.append(m)
        elif kind == 1:
            if prompt:
                y, kb, vb = swa_prompt(hn, p['w_swa_qkv'][j], p['b_swa_qkv'][j], p['swa_sinks'][j],
                                       p['w_swa_out'][j], p['b_swa_out'][j])
            else:
                y, kb, vb = swa_sample(hn, k_in[j], v_in[j], p['w_swa_qkv'][j], p['b_swa_qkv'][j],
                                       p['swa_sinks'][j], p['w_swa_out'][j], p['b_swa_out'][j])
            out_k.append(kb); out_v.append(vb)
        else:
            if prompt:
                h0 = jnp.zeros((bsz, C_WIDTH), f32)
                conv0 = jnp.zeros((bsz, CONV_W - 1, C_WIDTH), x.dtype)
            else:
                h0, conv0 = h_in[j], conv_in[j]
            y, h, cv = rglru_layer(hn, h0, conv0, p['w_rg_in'][j], p['w_rg_conv'][j], p['b_rg_conv'][j],
                                   p['w_rg_a'][j], p['b_rg_a'][j], p['w_rg_x'][j], p['b_rg_x'][j],
                                   p['rg_lambda'][j], p['w_rg_out'][j])
            out_h.append(h); out_conv.append(cv)
        x = x + y
        x = x + sqrelu_mlp(rmsnorm(x, p['norm_mlp'][i]), p['w_mlp_up'][i], p['w_mlp_down'][i])
    return (rmsnorm(x, p['norm_final']), jnp.stack(out_c), jnp.stack(out_n), jnp.stack(out_m),
            jnp.stack(out_k), jnp.stack(out_v), jnp.stack(out_h), jnp.stack(out_conv))


def setup_inputs(seed: int = 0) -> dict:
    key = jax.random.key(seed)
    ks = iter(jax.random.split(key, 48))
    f32 = jnp.float32

    def nrm(shape, scale):
        return scale * jax.random.normal(next(ks), shape, f32)

    swa_buf = min(WINDOW, PAST_LEN)
    a0 = jax.random.uniform(next(ks), (N_C, C_WIDTH), f32, 0.9, 0.999)
    return {
        'x_prompt': nrm((BATCH, SEQ, D_MODEL), 1.0),
        'x_sample': nrm((DEC_BATCH, DEC_SEQ, D_MODEL), 1.0),
        'state_mlstm_c': nrm((N_A, DEC_BATCH, A_HEADS, A_DV, A_DK), 0.1),
        'state_mlstm_n': nrm((N_A, DEC_BATCH, A_HEADS, A_DK), 0.1),
        'state_mlstm_m': nrm((N_A, DEC_BATCH, A_HEADS), 1.0),
        'cache_swa_k': nrm((N_B, DEC_BATCH, swa_buf, B_KV_HEADS, B_HD), 1.0),
        'cache_swa_v': nrm((N_B, DEC_BATCH, swa_buf, B_KV_HEADS, B_HD), 1.0),
        'state_rglru_h': nrm((N_C, DEC_BATCH, C_WIDTH), 0.5),
        'state_rglru_conv': nrm((N_C, DEC_BATCH, CONV_W - 1, C_WIDTH), 1.0),
        'norm_mix': 1.0 + nrm((DEPTH, D_MODEL), 0.02),
        'norm_mlp': 1.0 + nrm((DEPTH, D_MODEL), 0.02),
        'norm_final': 1.0 + nrm((D_MODEL,), 0.02),
        'w_mlp_up': nrm((DEPTH, D_MODEL, D_FF), D_MODEL ** -0.5),
        'w_mlp_down': nrm((DEPTH, D_FF, D_MODEL), D_FF ** -0.5),
        'w_mlstm_in': nrm((N_A, D_MODEL, A_IN), D_MODEL ** -0.5),
        'b_mlstm_i': nrm((N_A, A_HEADS), 0.1),
        'b_mlstm_f': 3.0 + nrm((N_A, A_HEADS), 0.1),
        'g_mlstm_head': 1.0 + nrm((N_A, A_HEADS, A_DV), 0.02),
        'w_mlstm_out': nrm((N_A, A_HEADS * A_DV, D_MODEL), (A_HEADS * A_DV) ** -0.5),
        'w_swa_qkv': nrm((N_B, D_MODEL, B_IN), D_MODEL ** -0.5),
        'b_swa_qkv': nrm((N_B, B_IN), 0.02),
        'swa_sinks': nrm((N_B, B_HEADS), 0.5),
        'w_swa_out': nrm((N_B, B_HEADS * B_HD, D_MODEL), (B_HEADS * B_HD) ** -0.5),
        'b_swa_out': nrm((N_B, D_MODEL), 0.02),
        'w_rg_in': nrm((N_C, D_MODEL, 2 * C_WIDTH), D_MODEL ** -0.5),
        'w_rg_conv': nrm((N_C, CONV_W, C_WIDTH), CONV_W ** -0.5),
        'b_rg_conv': nrm((N_C, C_WIDTH), 0.02),
        'w_rg_a': nrm((N_C, C_BLOCKS, C_BW, C_BW), C_BW ** -0.5),
        'b_rg_a': nrm((N_C, C_WIDTH), 0.02),
        'w_rg_x': nrm((N_C, C_BLOCKS, C_BW, C_BW), C_BW ** -0.5),
        'b_rg_x': nrm((N_C, C_WIDTH), 0.02),
        'rg_lambda': jnp.log(a0) - jnp.log1p(-a0),
        'w_rg_out': nrm((N_C, C_WIDTH, D_MODEL), C_WIDTH ** -0.5),
    }


def reference(x_prompt, x_sample, state_mlstm_c, state_mlstm_n, state_mlstm_m, cache_swa_k, cache_swa_v,
              state_rglru_h, state_rglru_conv, norm_mix, norm_mlp, norm_final, w_mlp_up, w_mlp_down,
              w_mlstm_in, b_mlstm_i, b_mlstm_f, g_mlstm_head, w_mlstm_out, w_swa_qkv, b_swa_qkv, swa_sinks,
              w_swa_out, b_swa_out, w_rg_in, w_rg_conv, b_rg_conv, w_rg_a, b_rg_a, w_rg_x, b_rg_x, rg_lambda,
              w_rg_out):
    p = {'norm_mix': norm_mix, 'norm_mlp': norm_mlp, 'norm_final': norm_final,
         'w_mlp_up': w_mlp_up, 'w_mlp_down': w_mlp_down,
         'w_mlstm_in': w_mlstm_in, 'b_mlstm_i': b_mlstm_i, 'b_mlstm_f': b_mlstm_f,
         'g_mlstm_head': g_mlstm_head, 'w_mlstm_out': w_mlstm_out,
         'w_swa_qkv': w_swa_qkv, 'b_swa_qkv': b_swa_qkv, 'swa_sinks': swa_sinks,
         'w_swa_out': w_swa_out, 'b_swa_out': b_swa_out,
         'w_rg_in': w_rg_in, 'w_rg_conv': w_rg_conv, 'b_rg_conv': b_rg_conv, 'w_rg_a': w_rg_a,
         'b_rg_a': b_rg_a, 'w_rg_x': w_rg_x, 'b_rg_x': b_rg_x, 'rg_lambda': rg_lambda, 'w_rg_out': w_rg_out}
    y_p, c_p, n_p, m_p, k_p, v_p, h_p, cv_p = trunk(x_prompt, True, None, None, None, None, None, None, None, p)
    y_s, c_s, n_s, m_s, k_s, v_s, h_s, cv_s = trunk(x_sample, False, state_mlstm_c, state_mlstm_n, state_mlstm_m,
                                                    cache_swa_k, cache_swa_v, state_rglru_h, state_rglru_conv, p)
    return (y_p, y_s, c_p, n_p, m_p, c_s, n_s, m_s, k_p, v_p, k_s, v_s, h_p, cv_p, h_s, cv_s)
```

```cpp
#include <hip/hip_runtime.h>
#include <hip/hip_cooperative_groups.h>
#include <cstdio>
#include <cstdint>
#include <utility>
namespace cg = cooperative_groups;

#ifndef SINGLE_LAUNCH
#define SINGLE_LAUNCH 1
#endif

#define LAS __attribute__((address_space(3)))
typedef unsigned short u16;
typedef short bf16x8 __attribute__((ext_vector_type(8)));
typedef float f32x4 __attribute__((ext_vector_type(4)));
typedef float f32x2 __attribute__((ext_vector_type(2)));
typedef unsigned u32x4 __attribute__((ext_vector_type(4)));
typedef unsigned u32x2 __attribute__((ext_vector_type(2)));

constexpr int MP = 16384, MS = 1024, MT = 17408, DM = 1024, SEQ = 8192;
constexpr int NPH = 36;
constexpr float EPS = 1e-6f;

__device__ __forceinline__ float bf2f(u16 b) { return __uint_as_float(((unsigned)b) << 16); }
__device__ __forceinline__ float bfs2f(short b) { return __uint_as_float(((unsigned)(u16)b) << 16); }
__device__ __forceinline__ unsigned cvt_pk_bf16(float lo, float hi) { unsigned r; asm volatile("v_cvt_pk_bf16_f32 %0, %1, %2" : "=v"(r) : "v"(lo), "v"(hi)); return r; }
__device__ __forceinline__ u16 f2bf(float f) { return (u16)(cvt_pk_bf16(f, 0.f) & 0xffffu); }
__device__ __forceinline__ float sigm(float x) { return 1.f / (1.f + __expf(-x)); }
__device__ __forceinline__ float logsig(float z) { return fminf(z, 0.f) - log1pf(__expf(-fabsf(z))); }
__device__ __forceinline__ float softplusf(float x) { return fmaxf(x, 0.f) + log1pf(__expf(-fabsf(x))); }
__device__ __forceinline__ bf16x8 ldg8(const u16* p) { return *(const bf16x8*)p; }
__device__ __forceinline__ bf16x8 pack8(const float* v) {
    u32x4 w; w.x = cvt_pk_bf16(v[0], v[1]); w.y = cvt_pk_bf16(v[2], v[3]); w.z = cvt_pk_bf16(v[4], v[5]); w.w = cvt_pk_bf16(v[6], v[7]);
    return __builtin_bit_cast(bf16x8, w);
}
__device__ __forceinline__ float gelu_tanh(float x) {
    const float u = 0.7978845608f * (x + 0.044715f * x * x * x);
    const float e = __expf(-2.f * fabsf(u));
    float t = (1.f - e) / (1.f + e); t = u < 0.f ? -t : t;
    return 0.5f * x * (1.f + t);
}

__device__ __forceinline__ int tid_opaque() { int t; asm volatile("v_mov_b32 %0, %1" : "=v"(t) : "v"((int)threadIdx.x)); return t; }
#define XB_TMO      128
#define XB_XCNT(j)  (256  + 64 * (j))
#define XB_XSUB(j)  (1280 + 64 * (j))
#define XB_XGEN(j)  (2304 + 64 * (j))
#define XB_TOP      3328
#define XB_TOPGEN   3392
#define XCD_BAR_WORDS 3456
#define XB_SPIN_CAP (1u << 20)
__device__ __forceinline__ unsigned xb_ld(unsigned* p)              { return __hip_atomic_load(p, __ATOMIC_RELAXED, __HIP_MEMORY_SCOPE_AGENT); }
__device__ __forceinline__ unsigned xb_add(unsigned* p, unsigned v) { return __hip_atomic_fetch_add(p, v, __ATOMIC_RELAXED, __HIP_MEMORY_SCOPE_AGENT); }
__device__ __forceinline__ unsigned xb_xcc_id() { return (unsigned)__builtin_amdgcn_s_getreg((3 << 11) | 20) & 0xFu; }
#define XB_SPIN(cond, bar) do { unsigned _sp = 0; while (cond) { __builtin_amdgcn_s_sleep(1); \
    if ((++_sp & 255u) == 0u) { if (xb_ld(&(bar)[XB_TMO])) break; if (_sp > XB_SPIN_CAP) { atomicAdd(&(bar)[XB_TMO], 1u); break; } } } } while (0)
struct XcdBarrier { unsigned* bar; unsigned x; volatile LAS unsigned* st; };
__device__ __forceinline__ XcdBarrier xcd_barrier_post(unsigned* bar, volatile LAS unsigned* st) {
    XcdBarrier b; b.bar = bar; b.x = xb_xcc_id(); b.st = st;
    if (threadIdx.x == 0) (void)xb_add(&bar[XB_XCNT(b.x)], 1u);
    return b;
}
__device__ __forceinline__ void xcd_barrier_complete(unsigned* bar, unsigned x, unsigned& nloc, unsigned& nx) {
    const unsigned G = gridDim.x * gridDim.y * gridDim.z;
    unsigned sum, cnt, mine, sp = 0u;
    for (;;) {
        sum = 0u; cnt = 0u; mine = 0u;
#pragma unroll
        for (unsigned j = 0; j < 16; ++j) { const unsigned c = xb_ld(&bar[XB_XCNT(j)]); sum += c; cnt += (c > 0u) ? 1u : 0u; mine = (j == x) ? c : mine; }
        if (sum == G) break;
        __builtin_amdgcn_s_sleep(1);
        if ((++sp & 255u) == 0u) { if (xb_ld(&bar[XB_TMO])) break; if (sp > XB_SPIN_CAP) { atomicAdd(&bar[XB_TMO], 1u); break; } }
    }
    nloc = mine > 0u ? mine : 1u; nx = cnt > 0u ? cnt : 1u;
}
__device__ __forceinline__ void xcd_barrier(const XcdBarrier& b) {
    asm volatile("s_waitcnt vmcnt(0)" ::: "memory");
    __syncthreads();
    if (threadIdx.x == 0) {
        unsigned* bar = b.bar;
        __builtin_amdgcn_s_waitcnt(0);
        unsigned nloc = b.st[0], nx = b.st[1];
        if (nloc == 0u) { xcd_barrier_complete(bar, b.x, nloc, nx); b.st[0] = nloc; b.st[1] = nx; }
        const unsigned old = xb_add(&bar[XB_XSUB(b.x)], 1u);
        const unsigned gen = old / nloc;
        if (old + 1u == (gen + 1u) * nloc) {
            __builtin_amdgcn_fence(__ATOMIC_RELEASE, "agent");
            asm volatile("s_waitcnt vmcnt(0)" ::: "memory");
            const unsigned og = xb_add(&bar[XB_TOP], 1u);
            const unsigned tg = og / nx;
            if (og + 1u == (tg + 1u) * nx) xb_add(&bar[XB_TOPGEN], 1u);
            else XB_SPIN(xb_ld(&bar[XB_TOPGEN]) == tg, bar);
            __builtin_amdgcn_fence(__ATOMIC_ACQUIRE, "agent");
            xb_add(&bar[XB_XGEN(b.x)], 1u);
            asm volatile("s_waitcnt vmcnt(0)" ::: "memory");
        } else {
            XB_SPIN(xb_ld(&bar[XB_XGEN(b.x)]) == gen, bar);
            __builtin_amdgcn_fence(__ATOMIC_ACQUIRE, "agent");
            asm volatile("s_waitcnt vmcnt(0)" ::: "memory");
        }
    }
    __syncthreads();
}

constexpr int NTILES_PREP = 3008;
struct Params {
    const float *xp, *xs, *st_c, *st_n, *st_m, *ck, *cv, *st_h, *st_conv, *norm_mix, *norm_mlp, *norm_final;
    const float *b_mi, *b_mf, *g_head, *b_qkv, *sinks, *b_sout, *w_conv, *b_conv, *b_a, *b_x, *lam;
    float* out;
    unsigned* bar; float* SS; float* SSP; f32x2* rope;
    u16 *wt_up, *wt_down, *wt_min, *wt_mout, *wt_qkv, *wt_sout, *wt_rgin, *wt_rgout, *wt_gate;
    u16* X; u16* XN; u16* ACT; unsigned char* MLS; u16* KS; u16* VTS;
    const float *w_up, *w_down, *w_min, *w_mout, *w_qkv, *w_sout, *w_rgin, *w_rgout, *w_a, *w_x;
    int p0, p1;
};
constexpr size_t O_YP = 0, O_YS = 16777216, O_CP = 17825792, O_NP = 18350080, O_MP = 18352128, O_CS = 18352144, O_NS = 51906576, O_MS = 52037648,
                 O_KP = 52038672, O_VP = 52104208, O_KS = 52169744, O_VS = 56364048, O_HP = 60558352, O_CVP = 60560400, O_HS = 60566544, O_CVS = 60697616, O_END = 61090832;
constexpr size_t ML_KT = 0;
constexpr size_t ML_DC = 16777216;
constexpr size_t ML_DN = ML_DC + 134217728;
constexpr size_t ML_META = ML_DN + 524288;
constexpr size_t ML_MC = ML_META + 8192;
constexpr size_t ML_G = ML_MC + 4096;
constexpr size_t ML_END = ML_G + 557056;
constexpr size_t SW_VTP = 0;
constexpr size_t RG_XB = 0, RG_GG = 35651584, RG_U = 2 * 35651584, RG_TA = 3 * 35651584, RG_TH = RG_TA + 1048576;
constexpr size_t ACT_BYTES = (size_t)MT * 4096 * 2;
constexpr size_t ACT_VT_OFF = (size_t)MT * 3072 * 2;

__device__ __forceinline__ const float* xin_row(const Params& p, int row) { return row < MP ? p.xp + (size_t)row * DM : p.xs + (size_t)(row - MP) * DM; }

namespace pg8 {
constexpr int BM = 256, BK = 64, HALF = 128, HTB = HALF * BK * 2, STAGE_BYTES = 8 * HTB, NXCD = 8, WGM = 8;
__host__ __device__ __forceinline__ int lds_byte(int r, int c) { const int st = (r >> 4) * 2 + (c >> 5), rr = r & 15, cc = c & 31, ob = rr * 64 + cc * 2; return st * 1024 + (ob ^ (((ob >> 9) & 1) << 5)); }
__host__ __device__ __forceinline__ void stage_rc(int b, int& R, int& C) { const int st = b / 1024, sb = b % 1024, swz = sb ^ (((sb >> 9) & 1) << 5); R = (st >> 1) * 16 + swz / 64; C = (st & 1) * 32 + (swz % 64) / 2; }
__host__ __device__ __forceinline__ int perm32(int rho) { const int n = rho >> 4, i = rho & 15; return 8 * (i >> 2) + 4 * n + (i & 3); }
struct Unit { int pm, pn, kb, nt, split; };
struct Gemm { const u16* A; const u16* Bt; int lda, ldb, K; };
struct StaticOrder {
    int nM, nN, nwg, G, c, acol_bytes, splitk, ntfull;
    __device__ void init(int nM_, int nN_, int G_, int c_, int acol_, int splitk_, int ntfull_) { nM = nM_; nN = nN_; nwg = nM * nN; G = G_; c = c_; acol_bytes = acol_; splitk = splitk_; ntfull = ntfull_; }
    __device__ __forceinline__ bool next(int i, int& u_pm, int& u_pn, int& u_kb, int& u_nt, int& u_split) const {
        const long L = (long)i * G + c;
        if (L >= nwg) {
            const int e = (int)(L - nwg);
            if (splitk == 0 || e >= 16 * splitk) return false;
            const int t16 = e / splitk, ks = e - t16 * splitk;
            u_pm = nM + (t16 >> 2); u_pn = t16 & 3; u_nt = ntfull / splitk; u_kb = ks * u_nt * 128; u_split = e; return true;
        }
        int wgid = (int)L; { const int q = nwg / NXCD, r = nwg % NXCD, xcd = wgid % NXCD, off = wgid / NXCD; wgid = (xcd < r ? xcd * (q + 1) : r * (q + 1) + (xcd - r) * q) + off; }
        const int nig = WGM * nN, gid = wgid / nig, fm = gid * WGM, gsz = (nM - fm) < WGM ? (nM - fm) : WGM;
        u_pm = fm + ((wgid % nig) % gsz); u_pn = (wgid % nig) / gsz; u_kb = 0; u_nt = ntfull; u_split = -1; return true;
    }
    __device__ __forceinline__ size_t acol(int pn) const { return (size_t)(pn >> 1) * (size_t)acol_bytes; }
};

template <class Epi>
__device__ __forceinline__ void gemm_phase(LAS unsigned char* lds, const Gemm g, const StaticOrder& S, const Epi& E) {
    const int tid = tid_opaque(), wid = __builtin_amdgcn_readfirstlane(tid >> 6), lane = tid & 63, wr = wid >> 2, wc = wid & 3, fr = lane & 15, fq = lane >> 4;
    unsigned voffA[2], voffB[2];
#pragma unroll
    for (int i = 0; i < 2; ++i) { int R, C; stage_rc(tid * 16 + i * 8192, R, C); const int Rb = Epi::PERM ? ((R & ~31) + perm32(R & 31)) : R;
        voffA[i] = (unsigned)(R * g.lda + C) * 2u; voffB[i] = (unsigned)(Rb * g.ldb + C) * 2u; }
    const size_t kstep = (size_t)(BK * 2);
    const size_t hstepA = (size_t)HALF * g.lda * 2, hstepB = (size_t)HALF * g.ldb * 2;
    const size_t tstepA = 2 * hstepA, tstepB = 2 * hstepB;
    const unsigned ldsw = (unsigned)wid * 1024u;
    const int aoff = lds_byte(wr * 64 + fr, fq * 8), boff = lds_byte(wc * 32 + fr, fq * 8);
#define PG8_SA(b, h) (((b) * 2 + (h)) * HTB)
#define PG8_SB(b, h) ((4 + (b) * 2 + (h)) * HTB)
#define PG8_STAGE(bufoff, gbase, voff) do { _Pragma("unroll") for (int _i = 0; _i < 2; ++_i) \
        __builtin_amdgcn_global_load_lds((const unsigned*)((const char*)(gbase) + (voff)[_i]), (LAS unsigned*)(lds + (bufoff) + ldsw + _i * 8192), 16, 0, 0); } while (0)
#define PG8_LDA(dst, b, h) do { _Pragma("unroll") for (int m = 0; m < 4; ++m) _Pragma("unroll") for (int k = 0; k < 2; ++k) dst[m][k] = *(const LAS bf16x8*)(lds + PG8_SA(b, h) + aoff + m * 2048 + k * 1024); } while (0)
#define PG8_LDB(dst, b, h) do { _Pragma("unroll") for (int n = 0; n < 2; ++n) _Pragma("unroll") for (int k = 0; k < 2; ++k) dst[n][k] = *(const LAS bf16x8*)(lds + PG8_SB(b, h) + boff + n * 2048 + k * 1024); } while (0)
#define PG8_MMA(ai, bj, At, Bt) do { __builtin_amdgcn_s_setprio(1); _Pragma("unroll") for (int m = 0; m < 4; ++m) _Pragma("unroll") for (int n = 0; n < 2; ++n) _Pragma("unroll") for (int k = 0; k < 2; ++k) \
        acc[ai][bj][m][n] = __builtin_amdgcn_mfma_f32_16x16x32_bf16(Bt[n][k], At[m][k], acc[ai][bj][m][n], 0, 0, 0); __builtin_amdgcn_s_setprio(0); } while (0)
#define PG8_WAIT_V(n) asm volatile("s_waitcnt vmcnt(" #n ")" ::: "memory")
#define PG8_WAIT_L(n) asm volatile("s_waitcnt lgkmcnt(" #n ")" ::: "memory")
#define PG8_BAR __builtin_amdgcn_s_barrier()
#define PG8_SCHED __builtin_amdgcn_sched_barrier(0)
    int c_pm, c_pn, c_kb, c_nt, c_split, n_pm = 0, n_pn = 0, n_kb = 0, n_nt = 2, n_split = -1; int ui = 0;
    if (!S.next(0, c_pm, c_pn, c_kb, c_nt, c_split)) return;
    f32x4 acc[2][2][4][2];
#pragma unroll
    for (int a = 0; a < 2; ++a)
#pragma unroll
        for (int b = 0; b < 2; ++b)
#pragma unroll
            for (int m = 0; m < 4; ++m)
#pragma unroll
                for (int n = 0; n < 2; ++n) acc[a][b][m][n] = (f32x4){0.f, 0.f, 0.f, 0.f};
    bf16x8 At[4][2], B0[2][2], B1[2][2];
    const char* cA = (const char*)g.A + (size_t)c_pm * tstepA + S.acol(c_pn) + c_kb; const char* cB = (const char*)g.Bt + (size_t)c_pn * tstepB + c_kb;
    float pre[8];
    E.pre(c_pm, wr, fr, pre);
    PG8_STAGE(PG8_SB(0, 0), cB, voffB); PG8_STAGE(PG8_SA(0, 0), cA, voffA); PG8_STAGE(PG8_SB(0, 1), cB + hstepB, voffB); PG8_STAGE(PG8_SA(0, 1), cA + hstepA, voffA);
    if (wr == 1) PG8_BAR;
    PG8_WAIT_V(4); PG8_BAR;
    PG8_STAGE(PG8_SB(1, 0), cB + kstep, voffB); PG8_STAGE(PG8_SA(1, 0), cA + kstep, voffA); PG8_STAGE(PG8_SB(1, 1), cB + hstepB + kstep, voffB);
    PG8_WAIT_V(6); PG8_BAR;
    for (;;) {
        const bool has_next = S.next(ui + 1, n_pm, n_pn, n_kb, n_nt, n_split);
        const char* nA = has_next ? (const char*)g.A + (size_t)n_pm * tstepA + S.acol(n_pn) + n_kb : cA; const char* nB = has_next ? (const char*)g.Bt + (size_t)n_pn * tstepB + n_kb : cB;
        const int nt = c_nt;
        for (int t = 0; t < nt; t += 2) {
            const bool last = (t == nt - 2);
            const char* a1 = cA + (size_t)(t + 1) * kstep;
            const char* a2 = last ? nA : cA + (size_t)(t + 2) * kstep; const char* b2 = last ? nB : cB + (size_t)(t + 2) * kstep;
            const char* a3 = a2 + kstep; const char* b3 = b2 + kstep;
            PG8_LDB(B0, 0, 0); PG8_SCHED; PG8_LDA(At, 0, 0); PG8_STAGE(PG8_SA(1, 1), a1 + hstepA, voffA);
            PG8_WAIT_L(8); PG8_BAR; PG8_WAIT_L(0); PG8_MMA(0, 0, At, B0); PG8_BAR; PG8_SCHED;
            PG8_LDB(B1, 0, 1); PG8_STAGE(PG8_SB(0, 0), b2, voffB);
            PG8_BAR; PG8_WAIT_L(0); PG8_MMA(0, 1, At, B1); PG8_BAR;
            PG8_LDA(At, 0, 1); PG8_STAGE(PG8_SA(0, 0), a2, voffA);
            PG8_BAR; PG8_WAIT_L(0); PG8_MMA(1, 0, At, B0); PG8_BAR; PG8_SCHED;
            PG8_STAGE(PG8_SB(0, 1), b2 + hstepB, voffB);
            PG8_WAIT_V(6); PG8_BAR; PG8_MMA(1, 1, At, B1); PG8_BAR;
            PG8_LDB(B0, 1, 0); PG8_SCHED; PG8_LDA(At, 1, 0); PG8_STAGE(PG8_SA(0, 1), a2 + hstepA, voffA);
            PG8_WAIT_L(8); PG8_BAR; PG8_WAIT_L(0); PG8_MMA(0, 0, At, B0); PG8_BAR; PG8_SCHED;
            PG8_LDB(B1, 1, 1); PG8_STAGE(PG8_SB(1, 0), b3, voffB);
            PG8_BAR; PG8_WAIT_L(0); PG8_MMA(0, 1, At, B1); PG8_BAR;
            PG8_LDA(At, 1, 1); PG8_STAGE(PG8_SA(1, 0), a3, voffA);
            PG8_BAR; PG8_WAIT_L(0); PG8_MMA(1, 0, At, B0); PG8_BAR; PG8_SCHED;
            PG8_STAGE(PG8_SB(1, 1), b3 + hstepB, voffB);
            PG8_WAIT_V(6); PG8_BAR; PG8_MMA(1, 1, At, B1); PG8_BAR;
        }
        { Unit cu; cu.pm = c_pm; cu.pn = c_pn; cu.kb = c_kb; cu.nt = c_nt; cu.split = c_split; E(acc, cu, wr, wc, fr, fq, pre); }
        if (!has_next) break;
#pragma unroll
        for (int a = 0; a < 2; ++a)
#pragma unroll
            for (int b = 0; b < 2; ++b)
#pragma unroll
                for (int m = 0; m < 4; ++m)
#pragma unroll
                    for (int n = 0; n < 2; ++n) acc[a][b][m][n] = (f32x4){0.f, 0.f, 0.f, 0.f};
        c_pm = n_pm; c_pn = n_pn; c_kb = n_kb; c_nt = n_nt; c_split = n_split; cA = nA; cB = nB; ++ui;
        E.pre(c_pm, wr, fr, pre);
    }
    PG8_WAIT_V(0);
    if (wr == 0) PG8_BAR;
    PG8_BAR;
#undef PG8_SA
#undef PG8_SB
#undef PG8_STAGE
#undef PG8_LDA
#undef PG8_LDB
#undef PG8_MMA
#undef PG8_WAIT_V
#undef PG8_WAIT_L
#undef PG8_BAR
#undef PG8_SCHED
}
}
using pg8::Unit;

typedef f32x4 Acc[2][2][4][2];

template <bool RF32>
struct EpiResid {
    static constexpr bool PERM = true;
    const float* rpf; const float* rsf; const u16* rx; u16* xout; const float* bias; float* slab; float* ss;
    __device__ __forceinline__ void pre(int, int, int, float (&pv)[8]) const {
#pragma unroll
        for (int i = 0; i < 8; ++i) pv[i] = 0.f;
    }
    __device__ __forceinline__ void operator()(const Acc& acc, const Unit u, int wr, int wc, int fr, int fq, const float (&pre)[8]) const {
        if (u.split >= 0) {
            u16* sb = (u16*)slab + (size_t)u.split * 65536 + (size_t)(wr * 64 + fr) * 256 + wc * 32 + 8 * fq;
#pragma unroll
            for (int ai = 0; ai < 2; ++ai)
#pragma unroll
                for (int m = 0; m < 4; ++m)
#pragma unroll
                    for (int bj = 0; bj < 2; ++bj) {
                        const f32x4 y0 = acc[ai][bj][m][0], y1 = acc[ai][bj][m][1];
                        u32x4 w; w.x = cvt_pk_bf16(y0[0], y0[1]); w.y = cvt_pk_bf16(y0[2], y0[3]); w.z = cvt_pk_bf16(y1[0], y1[1]); w.w = cvt_pk_bf16(y1[2], y1[3]);
                        *(u32x4*)(sb + (size_t)(ai * 128 + m * 16) * 256 + bj * 128) = w;
                    }
            return;
        }
        const int row0 = u.pm * 256 + wr * 64 + fr, col0 = u.pn * 256 + wc * 32 + 8 * fq;
        f32x4 bv[2][2];
#pragma unroll
        for (int bj = 0; bj < 2; ++bj)
#pragma unroll
            for (int n = 0; n < 2; ++n) bv[bj][n] = bias ? *(const f32x4*)(bias + col0 + bj * 128 + n * 4) : (f32x4){0.f, 0.f, 0.f, 0.f};
        if (RF32) {
#pragma unroll
            for (int aim = 0; aim < 4; ++aim) {
                const int ai = aim >> 1, mh = (aim & 1) * 2;
                __builtin_amdgcn_sched_barrier(0);
                f32x4 rv[2][2][2];
#pragma unroll
                for (int mm = 0; mm < 2; ++mm) {
                    const int r = row0 + ai * 128 + (mh + mm) * 16;
                    const float* rrow = (r < MP ? rpf + (size_t)r * DM : rsf + (size_t)(r - MP) * DM) + col0;
#pragma unroll
                    for (int bj = 0; bj < 2; ++bj)
#pragma unroll
                        for (int n = 0; n < 2; ++n) rv[mm][bj][n] = *(const f32x4*)(rrow + bj * 128 + n * 4);
                }
                __builtin_amdgcn_sched_barrier(0);
#pragma unroll
                for (int mm = 0; mm < 2; ++mm) {
                    const int m = mh + mm;
                    u16* orow = xout + (size_t)(row0 + ai * 128 + m * 16) * DM + col0;
                    float sq = 0.f;
#pragma unroll
                    for (int bj = 0; bj < 2; ++bj) {
                        const f32x4 y0 = acc[ai][bj][m][0] + rv[mm][bj][0] + bv[bj][0], y1 = acc[ai][bj][m][1] + rv[mm][bj][1] + bv[bj][1];
                        sq += y0[0] * y0[0] + y0[1] * y0[1] + y0[2] * y0[2] + y0[3] * y0[3] + y1[0] * y1[0] + y1[1] * y1[1] + y1[2] * y1[2] + y1[3] * y1[3];
                        u32x4 w; w.x = cvt_pk_bf16(y0[0], y0[1]); w.y = cvt_pk_bf16(y0[2], y0[3]); w.z = cvt_pk_bf16(y1[0], y1[1]); w.w = cvt_pk_bf16(y1[2], y1[3]);
                        *(u32x4*)(orow + bj * 128) = w;
                    }
                    if (ss) { sq += __shfl_xor(sq, 16); sq += __shfl_xor(sq, 32); if (fq == 0) ss[(size_t)(row0 + ai * 128 + m * 16) * 16 + u.pn * 4 + wc] = sq; }
                }
            }
        } else {
#pragma unroll
            for (int ai = 0; ai < 2; ++ai) {
                __builtin_amdgcn_sched_barrier(0);
                u32x4 raw[4][2];
#pragma unroll
                for (int m = 0; m < 4; ++m)
#pragma unroll
                    for (int bj = 0; bj < 2; ++bj) raw[m][bj] = *(const u32x4*)(rx + (size_t)(row0 + ai * 128 + m * 16) * DM + col0 + bj * 128);
                __builtin_amdgcn_sched_barrier(0);
#pragma unroll
                for (int m = 0; m < 4; ++m) {
                    u16* orow = xout + (size_t)(row0 + ai * 128 + m * 16) * DM + col0;
                    float sq = 0.f;
#pragma unroll
                    for (int bj = 0; bj < 2; ++bj) {
                        const u32x4 w0 = raw[m][bj];
                        const f32x4 r0 = (f32x4){__uint_as_float(w0.x << 16), __uint_as_float(w0.x & 0xffff0000u), __uint_as_float(w0.y << 16), __uint_as_float(w0.y & 0xffff0000u)};
                        const f32x4 r1 = (f32x4){__uint_as_float(w0.z << 16), __uint_as_float(w0.z & 0xffff0000u), __uint_as_float(w0.w << 16), __uint_as_float(w0.w & 0xffff0000u)};
                        const f32x4 y0 = acc[ai][bj][m][0] + r0 + bv[bj][0], y1 = acc[ai][bj][m][1] + r1 + bv[bj][1];
                        sq += y0[0] * y0[0] + y0[1] * y0[1] + y0[2] * y0[2] + y0[3] * y0[3] + y1[0] * y1[0] + y1[1] * y1[1] + y1[2] * y1[2] + y1[3] * y1[3];
                        u32x4 w; w.x = cvt_pk_bf16(y0[0], y0[1]); w.y = cvt_pk_bf16(y0[2], y0[3]); w.z = cvt_pk_bf16(y1[0], y1[1]); w.w = cvt_pk_bf16(y1[2], y1[3]);
                        *(u32x4*)(orow + bj * 128) = w;
                    }
                    if (ss) { sq += __shfl_xor(sq, 16); sq += __shfl_xor(sq, 32); if (fq == 0) ss[(size_t)(row0 + ai * 128 + m * 16) * 16 + u.pn * 4 + wc] = sq; }
                }
            }
        }
    }
};

struct EpiUp {
    static constexpr bool PERM = true;
    u16* U; const float* ss;
    __device__ __forceinline__ void pre(int pm, int wr, int fr, float (&pv)[8]) const {
#pragma unroll
        for (int ai = 0; ai < 2; ++ai)
#pragma unroll
            for (int m = 0; m < 4; ++m) pv[ai * 4 + m] = ss[pm * 256 + wr * 64 + fr + ai * 128 + m * 16];
    }
    __device__ __forceinline__ void operator()(const Acc& acc, const Unit u, int wr, int wc, int fr, int fq, const float (&pre)[8]) const {
        const int row0 = u.pm * 256 + wr * 64 + fr, col0 = u.pn * 256 + wc * 32 + 8 * fq;
        float rs[2][4];
#pragma unroll
        for (int ai = 0; ai < 2; ++ai)
#pragma unroll
            for (int m = 0; m < 4; ++m) rs[ai][m] = rsqrtf(pre[ai * 4 + m] * (1.f / 1024.f) + EPS);
#pragma unroll
        for (int ai = 0; ai < 2; ++ai)
#pragma unroll
            for (int m = 0; m < 4; ++m) {
                __builtin_amdgcn_sched_barrier(0);
                u16* orow = U + (size_t)(row0 + ai * 128 + m * 16) * 4096 + col0;
#pragma unroll
                for (int bj = 0; bj < 2; ++bj) {
                    float v[8];
#pragma unroll
                    for (int i = 0; i < 4; ++i) { float a = fmaxf(acc[ai][bj][m][0][i] * rs[ai][m], 0.f), b = fmaxf(acc[ai][bj][m][1][i] * rs[ai][m], 0.f); v[i] = a * a; v[4 + i] = b * b; }
                    *(bf16x8*)(orow + bj * 128) = pack8(v);
                }
            }
    }
};

struct EpiMlstmIn {
    static constexpr bool PERM = true;
    u16* P; u16* KT; u16* VT; float* G; const float* ss;
    __device__ __forceinline__ void pre(int pm, int wr, int fr, float (&pv)[8]) const {
#pragma unroll
        for (int ai = 0; ai < 2; ++ai)
#pragma unroll
            for (int m = 0; m < 4; ++m) pv[ai * 4 + m] = ss[pm * 256 + wr * 64 + fr + ai * 128 + m * 16];
    }
    __device__ __forceinline__ void operator()(const Acc& acc, const Unit u, int wr, int wc, int fr, int fq, const float (&pre)[8]) const {
        const int row0 = u.pm * 256 + wr * 64 + fr, colt = u.pn * 256 + wc * 32 + 8 * fq;
        float rs[2][4];
#pragma unroll
        for (int ai = 0; ai < 2; ++ai)
#pragma unroll
            for (int m = 0; m < 4; ++m) rs[ai][m] = rsqrtf(pre[ai * 4 + m] * (1.f / 1024.f) + EPS);
        const int pn = u.pn;
        if (pn == 12) {
            if (wc == 0 && fq == 0) {
#pragma unroll
                for (int ai = 0; ai < 2; ++ai)
#pragma unroll
                    for (int m = 0; m < 4; ++m) {
                        float* gr = G + (size_t)(row0 + ai * 128 + m * 16) * 8;
                        *(f32x4*)gr = acc[ai][0][m][0] * rs[ai][m]; *(f32x4*)(gr + 4) = acc[ai][0][m][1] * rs[ai][m];
                    }
            }
            return;
        }
        const int kind = pn < 2 ? 0 : (pn < 4 ? 1 : (pn < 8 ? 2 : 3));
#pragma unroll
        for (int ai = 0; ai < 2; ++ai)
#pragma unroll
            for (int m = 0; m < 4; ++m) {
                __builtin_amdgcn_sched_barrier(0);
                const int r = row0 + ai * 128 + m * 16;
#pragma unroll
                for (int bj = 0; bj < 2; ++bj) {
                    const int c0 = colt + bj * 128;
                    float v[8];
#pragma unroll
                    for (int i = 0; i < 4; ++i) { v[i] = acc[ai][bj][m][0][i] * rs[ai][m]; v[4 + i] = acc[ai][bj][m][1][i] * rs[ai][m]; }
                    if (kind == 1) {
#pragma unroll
                        for (int i = 0; i < 8; ++i) v[i] *= 0.08838834764831845f;
                    } else if (kind == 3) {
#pragma unroll
                        for (int i = 0; i < 8; ++i) v[i] = sigm(v[i]);
                    }
                    const bf16x8 w = pack8(v);
                    if (!(kind == 2 && r < MP)) *(bf16x8*)(P + (size_t)r * 3072 + c0) = w;
                    if (r < MP && (kind == 1 || kind == 2)) {
                        const int b = r >> 13, s = r & 8191;
                        u16* tb = (kind == 1) ? KT + ((size_t)(b * 512 + (c0 - 512)) * 8192 + s) : VT + ((size_t)(b * 1024 + (c0 - 1024)) * 8192 + s);
#pragma unroll
                        for (int i = 0; i < 8; ++i) tb[(size_t)i * 8192] = (u16)w[i];
                    }
                }
            }
    }
};

struct EpiSwaQkv {
    static constexpr bool PERM = true;
    u16* QKV; u16* VTp; u16* KS; u16* VTS; const float* bias; const f32x2* rope; float* out; const float* ss;
    __device__ __forceinline__ void pre(int pm, int wr, int fr, float (&pv)[8]) const {
#pragma unroll
        for (int ai = 0; ai < 2; ++ai)
#pragma unroll
            for (int m = 0; m < 4; ++m) pv[ai * 4 + m] = ss[pm * 256 + wr * 64 + fr + ai * 128 + m * 16];
    }
    __device__ __forceinline__ void operator()(const Acc& acc, const Unit u, int wr, int wc, int fr, int fq, const float (&pre)[8]) const {
        const int row0 = u.pm * 256 + wr * 64 + fr, colt = u.pn * 256 + wc * 32 + 8 * fq;
        float rs[2][4];
#pragma unroll
        for (int ai = 0; ai < 2; ++ai)
#pragma unroll
            for (int m = 0; m < 4; ++m) rs[ai][m] = rsqrtf(pre[ai * 4 + m] * (1.f / 1024.f) + EPS);
        const int pn = u.pn;
        const bool ropelane = ((wc & 1) == 0) && fq < 2;
        f32x4 bb[2][2];
#pragma unroll
        for (int bj = 0; bj < 2; ++bj) { bb[bj][0] = *(const f32x4*)(bias + colt + bj * 128); bb[bj][1] = *(const f32x4*)(bias + colt + bj * 128 + 4); }
#pragma unroll
        for (int aim = 0; aim < 4; ++aim) {
            const int ai = aim >> 1, mh = (aim & 1) * 2;
            __builtin_amdgcn_sched_barrier(0);
            f32x4 csv[2][4];
            if (pn < 5) {
#pragma unroll
                for (int mm = 0; mm < 2; ++mm) {
                    const int m = mh + mm;
                    const int r = row0 + ai * 128 + m * 16;
                    const int pos = r < MP ? (r & 8191) : 8192 + ((r - MP) & 7);
                    const f32x4* rp4 = (const f32x4*)(rope + (size_t)pos * 8);
#pragma unroll
                    for (int q = 0; q < 4; ++q) csv[mm][q] = rp4[q];
                }
            }
            __builtin_amdgcn_sched_barrier(0);
#pragma unroll
            for (int mm = 0; mm < 2; ++mm) {
                const int m = mh + mm;
                const int r = row0 + ai * 128 + m * 16;
                const bool prompt = r < MP;
                const int b = prompt ? (r >> 13) : ((r - MP) >> 3);
                const int s = prompt ? (r & 8191) : ((r - MP) & 7);
                f32x2 cs[8];
                if (pn < 5) {
#pragma unroll
                    for (int q = 0; q < 4; ++q) { cs[2 * q] = (f32x2){csv[mm][q][0], csv[mm][q][1]}; cs[2 * q + 1] = (f32x2){csv[mm][q][2], csv[mm][q][3]}; }
                }
#pragma unroll
                for (int bj = 0; bj < 2; ++bj) {
                    const int c0 = colt + bj * 128;
                    float v[8];
#pragma unroll
                    for (int i = 0; i < 4; ++i) { v[i] = acc[ai][bj][m][0][i] * rs[ai][m] + bb[bj][0][i]; v[4 + i] = acc[ai][bj][m][1][i] * rs[ai][m] + bb[bj][1][i]; }
                    if (pn < 5) {
#pragma unroll
                        for (int i = 0; i < 8; ++i) {
                            const float o = __shfl_xor(v[i], 16);
                            const float rot = (fq == 0) ? v[i] * cs[i].x - o * cs[i].y : v[i] * cs[i].x + o * cs[i].y;
                            v[i] = ropelane ? rot : v[i];
                        }
                    }
                    if (pn < 4) {
#pragma unroll
                        for (int i = 0; i < 8; ++i) v[i] *= 0.125f;
                    }
                    const bf16x8 w = pack8(v);
                    if (pn < 4 || (pn == 4 && prompt)) *(bf16x8*)(QKV + (size_t)r * 1536 + c0) = w;
                    if (pn == 4) {
                        const int cc = c0 - 1024, kvh = cc >> 6, d0 = cc & 63;
                        if (prompt) {
                            if (s >= 8064) { float* o = out + O_KP + ((size_t)(b * 128 + s - 8064)) * 256 + cc; *(f32x4*)o = (f32x4){v[0], v[1], v[2], v[3]}; *(f32x4*)(o + 4) = (f32x4){v[4], v[5], v[6], v[7]}; }
                        } else {
                            *(bf16x8*)(KS + ((size_t)((b * 4 + kvh) * 160 + 128 + s)) * 64 + d0) = w;
                            float* o = out + O_KS + ((size_t)(b * 128 + 120 + s)) * 256 + cc; *(f32x4*)o = (f32x4){v[0], v[1], v[2], v[3]}; *(f32x4*)(o + 4) = (f32x4){v[4], v[5], v[6], v[7]};
                        }
                    } else if (pn == 5) {
                        const int cc = c0 - 1280, kvh = cc >> 6, d0 = cc & 63;
                        if (prompt) {
                            u16* tb = VTp + ((size_t)((b * 4 + kvh) * 64 + d0)) * 8192 + s;
#pragma unroll
                            for (int i = 0; i < 8; ++i) tb[(size_t)i * 8192] = (u16)w[i];
                            if (s >= 8064) { float* o = out + O_VP + ((size_t)(b * 128 + s - 8064)) * 256 + cc; *(f32x4*)o = (f32x4){v[0], v[1], v[2], v[3]}; *(f32x4*)(o + 4) = (f32x4){v[4], v[5], v[6], v[7]}; }
                        } else {
                            u16* tb = VTS + ((size_t)((b * 4 + kvh) * 64 + d0)) * 160 + 128 + s;
#pragma unroll
                            for (int i = 0; i < 8; ++i) tb[(size_t)i * 160] = (u16)w[i];
                            float* o = out + O_VS + ((size_t)(b * 128 + 120 + s)) * 256 + cc; *(f32x4*)o = (f32x4){v[0], v[1], v[2], v[3]}; *(f32x4*)(o + 4) = (f32x4){v[4], v[5], v[6], v[7]};
                        }
                    }
                }
            }
        }
    }
};

struct EpiRgIn {
    static constexpr bool PERM = true;
    u16* XB; u16* GG; float* out; const float* ss;
    __device__ __forceinline__ void pre(int pm, int wr, int fr, float (&pv)[8]) const {
#pragma unroll
        for (int ai = 0; ai < 2; ++ai)
#pragma unroll
            for (int m = 0; m < 4; ++m) pv[ai * 4 + m] = ss[pm * 256 + wr * 64 + fr + ai * 128 + m * 16];
    }
    __device__ __forceinline__ void operator()(const Acc& acc, const Unit u, int wr, int wc, int fr, int fq, const float (&pre)[8]) const {
        const int row0 = u.pm * 256 + wr * 64 + fr, colt = u.pn * 256 + wc * 32 + 8 * fq;
        float rs[2][4];
#pragma unroll
        for (int ai = 0; ai < 2; ++ai)
#pragma unroll
            for (int m = 0; m < 4; ++m) rs[ai][m] = rsqrtf(pre[ai * 4 + m] * (1.f / 1024.f) + EPS);
        const bool isx = u.pn < 4;
#pragma unroll
        for (int ai = 0; ai < 2; ++ai)
#pragma unroll
            for (int m = 0; m < 4; ++m) {
                __builtin_amdgcn_sched_barrier(0);
                const int r = row0 + ai * 128 + m * 16;
#pragma unroll
                for (int bj = 0; bj < 2; ++bj) {
                    const int c0 = colt + bj * 128;
                    float v[8];
#pragma unroll
                    for (int i = 0; i < 4; ++i) { v[i] = acc[ai][bj][m][0][i] * rs[ai][m]; v[4 + i] = acc[ai][bj][m][1][i] * rs[ai][m]; }
                    if (isx) {
                        *(bf16x8*)(XB + (size_t)r * 1024 + c0) = pack8(v);
                        float* o = nullptr;
                        if (r < MP) { const int b = r >> 13, s = r & 8191; if (s >= 8189) o = out + O_CVP + ((size_t)(b * 3 + s - 8189)) * 1024 + c0; }
                        else { const int b = (r - MP) >> 3, s = (r - MP) & 7; if (s >= 5) o = out + O_CVS + ((size_t)(b * 3 + s - 5)) * 1024 + c0; }
                        if (o) { *(f32x4*)o = (f32x4){v[0], v[1], v[2], v[3]}; *(f32x4*)(o + 4) = (f32x4){v[4], v[5], v[6], v[7]}; }
                    } else {
#pragma unroll
                        for (int i = 0; i < 8; ++i) v[i] = gelu_tanh(v[i]);
                        *(bf16x8*)(GG + (size_t)r * 1024 + (c0 - 1024)) = pack8(v);
                    }
                }
            }
    }
};

struct EpiRgGate {
    static constexpr bool PERM = false;
    const u16* U; u16* LA; u16* BB; const float* b_a; const float* b_x; const float* lam;
    __device__ __forceinline__ void pre(int, int, int, float (&pv)[8]) const {
#pragma unroll
        for (int i = 0; i < 8; ++i) pv[i] = 0.f;
    }
    __device__ __forceinline__ void operator()(const Acc& acc, const Unit u, int wr, int wc, int fr, int fq, const float (&pre)[8]) const {
        const int row0 = u.pm * 256 + wr * 64 + fr;
        const int chb = (u.pn >> 1) * 256 + (u.pn & 1) * 128 + wc * 32 + 4 * fq;
        u32x2 uu[2][2][4];
#pragma unroll
        for (int n = 0; n < 2; ++n)
#pragma unroll
            for (int ai = 0; ai < 2; ++ai)
#pragma unroll
                for (int m = 0; m < 4; ++m) uu[n][ai][m] = *(const u32x2*)(U + (size_t)(row0 + ai * 128 + m * 16) * 1024 + chb + n * 16);
#pragma unroll
        for (int n = 0; n < 2; ++n) {
            const int ch = chb + n * 16;
            const f32x4 ba = *(const f32x4*)(b_a + ch), bx = *(const f32x4*)(b_x + ch), lm = *(const f32x4*)(lam + ch);
            float sp[4];
#pragma unroll
            for (int i = 0; i < 4; ++i) sp[i] = -8.f * softplusf(-lm[i]);
#pragma unroll
            for (int ai = 0; ai < 2; ++ai)
#pragma unroll
                for (int m = 0; m < 4; ++m) {
                    __builtin_amdgcn_sched_barrier(0);
                    const int r = row0 + ai * 128 + m * 16;
                    const u32x2 u2 = uu[n][ai][m];
                    const float uf[4] = {__uint_as_float(u2.x << 16), __uint_as_float(u2.x & 0xffff0000u), __uint_as_float(u2.y << 16), __uint_as_float(u2.y & 0xffff0000u)};
                    f32x4 av, bv;
#pragma unroll
                    for (int i = 0; i < 4; ++i) {
                        const float rr = sigm(acc[ai][0][m][n][i] + ba[i]);
                        const float gi = sigm(acc[ai][1][m][n][i] + bx[i]);
                        const float la = sp[i] * rr;
                        const float aa = __expf(la);
                        av[i] = la;
                        bv[i] = sqrtf(fmaxf(1.f - aa * aa, 0.f)) * gi * uf[i];
                    }
                    { u32x2 w; w.x = cvt_pk_bf16(av[0], av[1]); w.y = cvt_pk_bf16(av[2], av[3]); *(u32x2*)(LA + (size_t)r * 1024 + ch) = w; }
                    { u32x2 w; w.x = cvt_pk_bf16(bv[0], bv[1]); w.y = cvt_pk_bf16(bv[2], bv[3]); *(u32x2*)(BB + (size_t)r * 1024 + ch) = w; }
                }
        }
    }
};

template <int SET> __device__ __forceinline__ int wt_total() { return SET == 0 ? 208 : SET == 1 ? 576 : SET == 2 ? 672 : SET == 3 ? 768 : 784; }
template <int SET> __device__ __forceinline__ int wt_map(int v) {
    if (SET == 0) return 2048 + v;
    if (SET == 1) return v < 64 ? 2464 + v : (v < 320 ? v - 64 : 1024 + (v - 320));
    if (SET == 2) return v < 96 ? 2592 + v : (v < 160 ? 2688 + (v - 96) : (v < 416 ? 256 + (v - 160) : 1280 + (v - 416)));
    if (SET == 3) return v < 128 ? 2752 + v : (v < 192 ? 2880 + (v - 128) : (v < 256 ? 2944 + (v - 192) : (v < 512 ? 512 + (v - 256) : 1536 + (v - 512))));
    return v < 208 ? 2256 + v : (v < 272 ? 2528 + (v - 208) : (v < 528 ? 768 + (v - 272) : 1792 + (v - 528)));
}
template <int SET>
__device__ __forceinline__ void wt_tiles(const Params& p, int rank, int count) {
    const int tid = tid_opaque();
    const int wv_ = tid >> 6, ln_ = tid & 63;
    const int total = wt_total<SET>();
    for (int v0 = rank; v0 < total; v0 += 2 * count) {
        f32x4 v[2][8]; u16* dstp[2]; int dK[2]; bool dok[2];
#pragma unroll
        for (int q = 0; q < 2; ++q) {
            const int t = wt_map<SET>((v0 + q * count) < total ? (v0 + q * count) : v0);
            const float* jsrc; u16* jdst; int jK, jN, jld, lt;
            if (t < 1024) { const int l = t >> 8; jsrc = p.w_up + (size_t)l * 4194304; jdst = p.wt_up + (size_t)l * 4194304; jK = 1024; jN = 4096; jld = 4096; lt = t & 255; }
            else if (t < 2048) { const int x = t - 1024, l = x >> 8; jsrc = p.w_down + (size_t)l * 4194304; jdst = p.wt_down + (size_t)l * 4194304; jK = 4096; jN = 1024; jld = 1024; lt = x & 255; }
            else if (t < 2464) { const int x = t - 2048, l = x / 208; jsrc = p.w_min + (size_t)l * 1024 * 3080; jdst = p.wt_min + (size_t)l * 3328 * 1024; jK = 1024; jN = 3080; jld = 3080; lt = x - l * 208; }
            else if (t < 2592) { const int x = t - 2464, l = x >> 6; jsrc = p.w_mout + (size_t)l * 1048576; jdst = p.wt_mout + (size_t)l * 1048576; jK = 1024; jN = 1024; jld = 1024; lt = x & 63; }
            else if (t < 2688) { jsrc = p.w_qkv; jdst = p.wt_qkv; jK = 1024; jN = 1536; jld = 1536; lt = t - 2592; }
            else if (t < 2752) { jsrc = p.w_sout; jdst = p.wt_sout; jK = 1024; jN = 1024; jld = 1024; lt = t - 2688; }
            else if (t < 2880) { jsrc = p.w_rgin; jdst = p.wt_rgin; jK = 1024; jN = 2048; jld = 2048; lt = t - 2752; }
            else if (t < 2944) { jsrc = p.w_rgout; jdst = p.wt_rgout; jK = 1024; jN = 1024; jld = 1024; lt = t - 2880; }
            else { const int x = t - 2944, jj = x >> 2, n = jj >> 2, half = (jj >> 1) & 1, which = jj & 1;
                jsrc = (which ? p.w_x : p.w_a) + (size_t)n * 65536 + half * 128; jdst = p.wt_gate + ((size_t)(n * 2 + half) * 256 + which * 128) * 256; jK = 256; jN = 128; jld = 256; lt = x & 3; }
            const int nkt = jK >> 6, nt_ = lt / nkt, kt_ = lt - nt_ * nkt;
            const int n = nt_ * 256 + 4 * ln_, k0 = kt_ * 64 + 8 * wv_;
            const bool isgate = t >= 2944;
            const float* gk = nullptr;
            if (t < 1024) gk = p.norm_mlp + (t >> 8) * 1024;
            else if (t >= 2048 && t < 2464) gk = p.norm_mix + ((t - 2048) / 208) * 3072;
            else if (t >= 2592 && t < 2688) gk = p.norm_mix + 1024;
            else if (t >= 2752 && t < 2880) gk = p.norm_mix + 2048;
#pragma unroll
            for (int i = 0; i < 8; ++i) v[q][i] = (f32x4){0.f, 0.f, 0.f, 0.f};
            if (n < jN) {
#pragma unroll
                for (int i = 0; i < 8; ++i) v[q][i] = *(const f32x4*)(jsrc + (size_t)(k0 + i) * jld + n);
                if (gk) {
#pragma unroll
                    for (int i = 0; i < 8; ++i) v[q][i] *= gk[k0 + i];
                }
            }
            dstp[q] = jdst + (size_t)n * jK + k0; dK[q] = jK;
            dok[q] = (!isgate || n < 128) && (q == 0 || (v0 + count) < total);
        }
#pragma unroll
        for (int q = 0; q < 2; ++q) {
            if (dok[q]) {
#pragma unroll
                for (int c = 0; c < 4; ++c) {
                    const float f[8] = {v[q][0][c], v[q][1][c], v[q][2][c], v[q][3][c], v[q][4][c], v[q][5][c], v[q][6][c], v[q][7][c]};
                    *(bf16x8*)(dstp[q] + (size_t)c * dK[q]) = pack8(f);
                }
            }
        }
    }
}

__device__ __forceinline__ void misc_prep(const Params& p, int rank, int count) {
    const int tid = tid_opaque();
    const int gt = rank * 512 + tid, gs = count * 512;
    for (int i = gt; i < 8200 * 8; i += gs) {
        const int pos = i >> 3, f = i & 7;
        const float inv = powf(500000.0f, -(float)(2 * f) / 16.0f);
        const float ang = (float)pos * inv;
        p.rope[i] = (f32x2){cosf(ang), sinf(ang)};
    }
    {
        constexpr int NU = 128 * 4 * 160 * 8;
        const int nit = (NU + gs - 1) / gs;
        for (int it0 = 0; it0 < nit; it0 += 4) {
            f32x4 kv[4][2], vv[4][2];
#pragma unroll
            for (int q = 0; q < 4; ++q) {
                int i = gt + (it0 + q) * gs; i = i < NU ? i : NU - 1;
                const int d8 = i & 7, key = (i >> 3) % 160, bk = i / 1280, b = bk >> 2, kvh = bk & 3;
                const int keyc = key < 128 ? key : 0;
                const size_t src = ((size_t)(b * 128 + keyc)) * 256 + kvh * 64 + d8 * 8;
                kv[q][0] = *(const f32x4*)(p.ck + src); kv[q][1] = *(const f32x4*)(p.ck + src + 4);
                vv[q][0] = *(const f32x4*)(p.cv + src); vv[q][1] = *(const f32x4*)(p.cv + src + 4);
            }
#pragma unroll
            for (int q = 0; q < 4; ++q) {
                const int i = gt + (it0 + q) * gs;
                if (i < NU) {
                    const int d8 = i & 7, key = (i >> 3) % 160, bk = i / 1280;
                    if (key < 128 || key >= 136) {
                        const bool z = key >= 136;
                        float kf[8], vf[8];
#pragma unroll
                        for (int e = 0; e < 4; ++e) { kf[e] = z ? 0.f : kv[q][0][e]; kf[4 + e] = z ? 0.f : kv[q][1][e]; vf[e] = z ? 0.f : vv[q][0][e]; vf[4 + e] = z ? 0.f : vv[q][1][e]; }
                        *(bf16x8*)(p.KS + (size_t)i * 8) = pack8(kf);
                        const bf16x8 vw = pack8(vf);
#pragma unroll
                        for (int e = 0; e < 8; ++e) p.VTS[((size_t)bk * 64 + d8 * 8 + e) * 160 + key] = (u16)vw[e];
                    }
                }
            }
        }
    }
}

__device__ __forceinline__ void cache_copy(const Params& p, int rank, int count) {
    const int tid = tid_opaque();
    const int gt = rank * 512 + tid, gs = count * 512;
    {
        constexpr int NU = 128 * 120 * 64;
        const int nit = (NU + gs - 1) / gs;
        for (int it0 = 0; it0 < nit; it0 += 4) {
            f32x4 kv[4], vv[4];
#pragma unroll
            for (int q = 0; q < 4; ++q) {
                int i = gt + (it0 + q) * gs; i = i < NU ? i : NU - 1;
                const int q4 = i & 63, rr = (i >> 6) % 120, b = i / (120 * 64);
                const size_t so = ((size_t)(b * 128 + rr + 8)) * 256 + q4 * 4;
                kv[q] = *(const f32x4*)(p.ck + so); vv[q] = *(const f32x4*)(p.cv + so);
            }
#pragma unroll
            for (int q = 0; q < 4; ++q) {
                const int i = gt + (it0 + q) * gs;
                if (i < NU) {
                    const int q4 = i & 63, rr = (i >> 6) % 120, b = i / (120 * 64);
                    const size_t dd = ((size_t)(b * 128 + rr)) * 256 + q4 * 4;
                    *(f32x4*)(p.out + O_KS + dd) = kv[q]; *(f32x4*)(p.out + O_VS + dd) = vv[q];
                }
            }
        }
    }
}

template <int KIND, int SPLITK, bool SRES_F32>
__device__ __forceinline__ void norm_phase(const Params& p, const float* g, float* ss, const float* sres32, const float* bias) {
    const int tid = tid_opaque(); const int lane = tid & 63, wv = (blockIdx.x * 512 + tid) >> 6, nw = gridDim.x * 8;
    const float* slab = (const float*)(p.MLS + ML_DC);
    auto sumsq = [&](const f32x4 (&v)[4]) {
        float sq = 0.f;
#pragma unroll
        for (int q = 0; q < 4; ++q) sq += v[q][0] * v[q][0] + v[q][1] * v[q][1] + v[q][2] * v[q][2] + v[q][3] * v[q][3];
#pragma unroll
        for (int o = 32; o; o >>= 1) sq += __shfl_xor(sq, o);
        return sq;
    };
    auto stx = [&](int r, const f32x4 (&v)[4]) {
#pragma unroll
        for (int i = 0; i < 2; ++i) {
            u32x4 w; w.x = cvt_pk_bf16(v[2 * i][0], v[2 * i][1]); w.y = cvt_pk_bf16(v[2 * i][2], v[2 * i][3]); w.z = cvt_pk_bf16(v[2 * i + 1][0], v[2 * i + 1][1]); w.w = cvt_pk_bf16(v[2 * i + 1][2], v[2 * i + 1][3]);
            *(u32x4*)(p.X + (size_t)r * DM + lane * 8 + 512 * i) = w;
        }
    };
    auto ldx = [&](const u16* row, f32x4 (&v)[4]) {
#pragma unroll
        for (int i = 0; i < 2; ++i) {
            const u32x4 w = *(const u32x4*)(row + lane * 8 + 512 * i);
            v[2 * i] = (f32x4){__uint_as_float(w.x << 16), __uint_as_float(w.x & 0xffff0000u), __uint_as_float(w.y << 16), __uint_as_float(w.y & 0xffff0000u)};
            v[2 * i + 1] = (f32x4){__uint_as_float(w.z << 16), __uint_as_float(w.z & 0xffff0000u), __uint_as_float(w.w << 16), __uint_as_float(w.w & 0xffff0000u)};
        }
    };
    auto ldf = [&](const float* row, f32x4 (&v)[4]) {
#pragma unroll
        for (int q = 0; q < 4; ++q) v[q] = *(const f32x4*)(row + lane * 8 + 512 * (q >> 1) + 4 * (q & 1));
    };
    if (KIND == 0) {
        for (int r = wv; r < MT; r += 2 * nw) {
            const int rb = r + nw; const bool hasb = rb < MT; const int rbc = hasb ? rb : r;
            f32x4 va[4], vb[4];
            ldf(xin_row(p, r), va); ldf(xin_row(p, rbc), vb);
            stx(r, va); const float sa = sumsq(va); if (lane == 0) ss[r] = sa;
            if (hasb) { stx(rb, vb); const float sb = sumsq(vb); if (lane == 0) ss[rb] = sb; }
        }
        return;
    }
    f32x4 gv[4];
    if (KIND == 2) {
#pragma unroll
        for (int q = 0; q < 4; ++q) gv[q] = *(const f32x4*)(g + lane * 8 + 512 * (q >> 1) + 4 * (q & 1));
    }
    auto fin = [&](int r, const f32x4 (&v)[4]) {
        const float rs = rsqrtf(sumsq(v) * (1.f / 1024.f) + EPS);
#pragma unroll
        for (int q = 0; q < 4; ++q) *(f32x4*)(p.out + (size_t)r * DM + lane * 8 + 512 * (q >> 1) + 4 * (q & 1)) = v[q] * rs * gv[q];
    };
    for (int r0 = wv; r0 < MS; r0 += nw) {
        const int r = MP + r0;
        f32x4 v[4];
        if (SRES_F32) ldf(sres32 + (size_t)r0 * DM, v); else ldx(p.X + (size_t)r * DM, v);
        const int t4 = (r0 >> 8) * 4;
        const u16* slabh = (const u16*)slab;
        u32x4 part[2][SPLITK > 0 ? SPLITK : 1];
#pragma unroll
        for (int i = 0; i < 2; ++i) {
            const int col = lane * 8 + 512 * i;
            const u16* sp = slabh + (size_t)((t4 + (col >> 8)) * SPLITK) * 65536 + (size_t)(r0 & 255) * 256 + (col & 255);
#pragma unroll
            for (int k = 0; k < SPLITK; ++k) part[i][k] = *(const u32x4*)(sp + (size_t)k * 65536);
        }
#pragma unroll
        for (int i = 0; i < 2; ++i) {
            const int col = lane * 8 + 512 * i;
            if (bias) { v[2 * i] += *(const f32x4*)(bias + col); v[2 * i + 1] += *(const f32x4*)(bias + col + 4); }
#pragma unroll
            for (int k = 0; k < SPLITK; ++k) {
                const u32x4 w = part[i][k];
                v[2 * i] += (f32x4){__uint_as_float(w.x << 16), __uint_as_float(w.x & 0xffff0000u), __uint_as_float(w.y << 16), __uint_as_float(w.y & 0xffff0000u)};
                v[2 * i + 1] += (f32x4){__uint_as_float(w.z << 16), __uint_as_float(w.z & 0xffff0000u), __uint_as_float(w.w << 16), __uint_as_float(w.w & 0xffff0000u)};
            }
        }
        if (KIND == 1) { stx(r, v); const float sq = sumsq(v); if (lane == 0) ss[r] = sq; }
        else fin(r, v);
    }
    if (KIND == 1) {
        for (int r = blockIdx.x * 512 + tid; r < MP; r += gridDim.x * 512) {
            const f32x4* pp = (const f32x4*)(p.SSP + (size_t)r * 16);
            const f32x4 a0 = pp[0], a1 = pp[1], a2 = pp[2], a3 = pp[3];
            ss[r] = (((a0[0] + a0[1]) + (a0[2] + a0[3])) + ((a1[0] + a1[1]) + (a1[2] + a1[3]))) + (((a2[0] + a2[1]) + (a2[2] + a2[3])) + ((a3[0] + a3[1]) + (a3[2] + a3[3])));
        }
    }
    if (KIND == 2) {
        for (int r = wv; r < MP; r += 2 * nw) {
            const int rb = r + nw; const bool hasb = rb < MP; const int rbc = hasb ? rb : r;
            f32x4 va[4], vb[4];
            ldx(p.X + (size_t)r * DM, va); ldx(p.X + (size_t)rbc * DM, vb);
            fin(r, va);
            if (hasb) fin(rb, vb);
        }
    }
}

#define MFMA16(a, b, c) __builtin_amdgcn_mfma_f32_16x16x32_bf16(a, b, c, 0, 0, 0)

__device__ __forceinline__ void mlstm_s1(const Params& p, int j) {
    const int tid = tid_opaque(), wv = tid >> 6, lane = tid & 63, fr = lane & 15, fq = lane >> 4;
    const u16* KT = (const u16*)(p.MLS + ML_KT); const u16* VT = (const u16*)((unsigned char*)p.ACT + ACT_VT_OFF);
    u16* DC = (u16*)(p.MLS + ML_DC); float* DN = (float*)(p.MLS + ML_DN); float* META = (float*)(p.MLS + ML_META);
    const float* G = (const float*)(p.MLS + ML_G);
    for (int item = blockIdx.x; item < 1024; item += gridDim.x) {
        const int bh = item >> 7, c = item & 127, b = bh >> 2, h = bh & 3;
        const int row0 = b * 8192 + c * 64;
        bf16x8 kfa[2][8], vra[2][2];
#pragma unroll
        for (int ks = 0; ks < 2; ++ks) {
#pragma unroll
            for (int kt = 0; kt < 8; ++kt) kfa[ks][kt] = ldg8(KT + ((size_t)(bh * 128 + 16 * kt + fr)) * 8192 + c * 64 + 32 * ks + 8 * fq);
#pragma unroll
            for (int vt = 0; vt < 2; ++vt) vra[ks][vt] = ldg8(VT + ((size_t)(bh * 256 + 32 * wv + 16 * vt + fr)) * 8192 + c * 64 + 32 * ks + 8 * fq);
        }
        const u16* kp = KT + ((size_t)(bh * 128 + 16 * wv + fr)) * 8192 + c * 64 + 16 * fq;
        const bf16x8 k0 = ldg8(kp), k1 = ldg8(kp + 8);
        const float ipre = G[(size_t)(row0 + lane) * 8 + h] + p.b_mi[j * 4 + h];
        const float lf = logsig(G[(size_t)(row0 + lane) * 8 + 4 + h] + p.b_mf[j * 4 + h]);
        float bt = lf;
#pragma unroll
        for (int o = 1; o < 64; o <<= 1) { const float t = __shfl_up(bt, o); if (lane >= o) bt += t; }
        const float g = __shfl(bt, 63);
        const float a = g - bt + ipre;
        float amax = a;
#pragma unroll
        for (int o = 32; o; o >>= 1) amax = fmaxf(amax, __shfl_xor(amax, o));
        const float w = __expf(a - amax);
        f32x4 acc[8][2];
#pragma unroll
        for (int kt = 0; kt < 8; ++kt) { acc[kt][0] = (f32x4){0.f, 0.f, 0.f, 0.f}; acc[kt][1] = (f32x4){0.f, 0.f, 0.f, 0.f}; }
#pragma unroll
        for (int ks = 0; ks < 2; ++ks) {
            float ws[8];
#pragma unroll
            for (int i = 0; i < 8; ++i) ws[i] = __shfl(w, 32 * ks + 8 * fq + i);
            bf16x8 vf[2];
#pragma unroll
            for (int vt = 0; vt < 2; ++vt) {
                const bf16x8 raw = vra[ks][vt];
                float f[8];
#pragma unroll
                for (int i = 0; i < 8; ++i) f[i] = bfs2f(raw[i]) * ws[i];
                vf[vt] = pack8(f);
            }
#pragma unroll
            for (int kt = 0; kt < 8; ++kt) {
                const bf16x8 kf = kfa[ks][kt];
                acc[kt][0] = MFMA16(kf, vf[0], acc[kt][0]);
                acc[kt][1] = MFMA16(kf, vf[1], acc[kt][1]);
            }
        }
#pragma unroll
        for (int kt = 0; kt < 8; ++kt)
#pragma unroll
            for (int vt = 0; vt < 2; ++vt)
                { u32x2 w2; w2.x = cvt_pk_bf16(acc[kt][vt][0], acc[kt][vt][1]); w2.y = cvt_pk_bf16(acc[kt][vt][2], acc[kt][vt][3]);
                  *(u32x2*)(DC + ((size_t)item * 256 + 32 * wv + 16 * vt + fr) * 128 + 16 * kt + 4 * fq) = w2; }
        {
            float sacc = 0.f;
#pragma unroll
            for (int i = 0; i < 8; ++i) { sacc += __shfl(w, 16 * fq + i) * bfs2f(k0[i]); sacc += __shfl(w, 16 * fq + 8 + i) * bfs2f(k1[i]); }
            sacc += __shfl_xor(sacc, 16); sacc += __shfl_xor(sacc, 32);
            if (fq == 0) DN[(size_t)item * 128 + 16 * wv + fr] = sacc;
        }
        if (tid == 0) { META[item * 2] = g; META[item * 2 + 1] = amax; }
    }
}

__device__ __forceinline__ void mlstm_sample(const Params& p, int j, LAS unsigned char* lds) {
    const int tid = tid_opaque(), lane = tid & 63, wv = tid >> 6;
    const u16* P = p.ACT; const float* G = (const float*)(p.MLS + ML_G);
    LAS float* qs = (LAS float*)lds;
    LAS float* ks = qs + 1024;
    LAS float* vs = ks + 1024;
    LAS float* sw = vs + 2048;
    LAS float* sc = sw + 64;
    LAS float* red = sc + 64;
    LAS float* n0s = red + 64;
    LAS float* gpre = n0s + 128;
    for (int item = blockIdx.x; item < 512; item += gridDim.x) {
        const int b = item >> 2, h = item & 3;
        const int row0 = MP + b * 8;
        const size_t sidx = (size_t)((j * 128 + b) * 4 + h);
        const float* c0 = p.st_c + sidx * 32768; const float* n0 = p.st_n + sidx * 128; const float m0 = p.st_m[sidx];
        for (int i = tid; i < 1024; i += 512) { const int t = i >> 7, k = i & 127; qs[i] = bf2f(P[(size_t)(row0 + t) * 3072 + h * 128 + k]); ks[i] = bf2f(P[(size_t)(row0 + t) * 3072 + 512 + h * 128 + k]); }
        for (int i = tid; i < 2048; i += 512) { const int t = i >> 8, v = i & 255; vs[i] = bf2f(P[(size_t)(row0 + t) * 3072 + 1024 + h * 256 + v]); }
        if (tid < 128) n0s[tid] = n0[tid];
        else if (tid < 144) { const int x = tid - 128; gpre[x] = G[(size_t)(row0 + (x & 7)) * 8 + (x >> 3) * 4 + h] + (x < 8 ? p.b_mi[j * 4 + h] : p.b_mf[j * 4 + h]); }
        __syncthreads();
        if (tid == 0) {
            float bt = 0.f, m = m0, btv[8], igv[8], mtv[8];
#pragma unroll
            for (int t = 0; t < 8; ++t) {
                const float ig = gpre[t];
                const float lf = logsig(gpre[8 + t]);
                bt += lf; m = fmaxf(lf + m, ig);
                btv[t] = bt; igv[t] = ig; mtv[t] = m;
                sc[t] = bt; sc[8 + t] = ig; sc[16 + t] = m; sc[24 + t] = __expf(bt + m0 - m);
            }
            const float mnew = mtv[7];
            for (int s = 0; s < 8; ++s) sc[32 + s] = __expf(btv[7] - btv[s] + igv[s] - mnew);
            sc[40] = __expf(btv[7] + m0 - mnew);
            p.out[O_MS + sidx] = mnew;
        }
        __syncthreads();
        if (tid < 64) {
            const int t = tid >> 3, s = tid & 7;
            float r = 0.f;
            if (s <= t) { float d = 0.f; for (int k = 0; k < 128; ++k) d += qs[t * 128 + k] * ks[s * 128 + k]; r = d * __expf(sc[t] - sc[s] + sc[8 + s] - sc[16 + t]); }
            sw[tid] = r;
        } else if (tid < 72) {
            const int t = tid - 64; float d = 0.f; for (int k = 0; k < 128; ++k) d += qs[t * 128 + k] * n0s[k];
            sc[48 + t] = d;
        }
        __syncthreads();
        const int v = tid >> 1, half = tid & 1;
        float dv[8], cq[8];
#pragma unroll
        for (int s = 0; s < 8; ++s) { dv[s] = sc[32 + s] * vs[s * 256 + v]; cq[s] = 0.f; }
        const float carry = sc[40];
        float* cout = p.out + O_CS + sidx * 32768 + (size_t)v * 128 + half * 64;
        const float* cin = c0 + (size_t)v * 128 + half * 64;
#pragma unroll 8
        for (int kk = 0; kk < 16; ++kk) {
            const f32x4 cv = *(const f32x4*)(cin + kk * 4);
            f32x4 nv = cv * carry;
#pragma unroll
            for (int t = 0; t < 8; ++t) {
                const f32x4 qv = *(const LAS f32x4*)(qs + t * 128 + half * 64 + kk * 4);
                const f32x4 kv = *(const LAS f32x4*)(ks + t * 128 + half * 64 + kk * 4);
                cq[t] += cv[0] * qv[0] + cv[1] * qv[1] + cv[2] * qv[2] + cv[3] * qv[3];
                nv += kv * dv[t];
            }
            *(f32x4*)(cout + kk * 4) = nv;
        }
        if (tid < 128) {
            float nn = carry * n0s[tid];
#pragma unroll
            for (int s = 0; s < 8; ++s) nn += sc[32 + s] * ks[s * 128 + tid];
            p.out[O_NS + sidx * 128 + tid] = nn;
        }
        float hv[8], hsq[8];
#pragma unroll
        for (int t = 0; t < 8; ++t) {
            cq[t] += __shfl_xor(cq[t], 1);
            float num = 0.f, den = 0.f;
#pragma unroll
            for (int s = 0; s < 8; ++s) { const float x = sw[t * 8 + s]; num += x * vs[s * 256 + v]; den += x; }
            const float wi = sc[24 + t];
            num += wi * cq[t]; den += wi * sc[48 + t];
            hv[t] = num / fmaxf(fabsf(den), __expf(-sc[16 + t]));
            hsq[t] = half == 0 ? hv[t] * hv[t] : 0.f;
#pragma unroll
            for (int o = 32; o; o >>= 1) hsq[t] += __shfl_xor(hsq[t], o);
        }
        if (lane == 0) {
#pragma unroll
            for (int t = 0; t < 8; ++t) red[wv * 8 + t] = hsq[t];
        }
        __syncthreads();
        if (half == 0) {
            const float gh = p.g_head[(j * 4 + h) * 256 + v];
#pragma unroll
            for (int t = 0; t < 8; ++t) {
                float tot = 0.f;
#pragma unroll
                for (int w8 = 0; w8 < 8; ++w8) tot += red[w8 * 8 + t];
                const float rs = rsqrtf(tot * (1.f / 256.f) + EPS);
                const float og = bf2f(P[(size_t)(row0 + t) * 3072 + 2048 + h * 256 + v]);
                p.XN[(size_t)(row0 + t) * 1024 + h * 256 + v] = f2bf(hv[t] * rs * gh * og);
            }
        }
        __syncthreads();
    }
}

__device__ __forceinline__ void mlstm_s2(const Params& p, int j, LAS unsigned char* lds) {
    const int tid = tid_opaque();
    u16* DC = (u16*)(p.MLS + ML_DC); float* DN = (float*)(p.MLS + ML_DN); const float* META = (const float*)(p.MLS + ML_META); float* MC = (float*)(p.MLS + ML_MC);
    LAS float* sg = (LAS float*)lds; LAS float* sa = sg + 128; LAS float* scl = sa + 128; LAS float* sdl = scl + 128;
    for (int u = blockIdx.x; u < 256; u += gridDim.x) {
        const int bh = u >> 5, slice = u & 31, b = bh >> 2, h = bh & 3;
        const bool act = tid < 128;
        const size_t e = (size_t)slice * 1024 + (size_t)(tid & 127) * 8;
        u32x4* base = (u32x4*)(DC + (size_t)bh * 128 * 32768 + e);
        u32x4 d0[16], d1[16];
        if (act) {
#pragma unroll
            for (int i = 0; i < 16; ++i) d0[i] = base[(size_t)i * 4096];
        }
        if (tid < 128) { sg[tid] = META[(bh * 128 + tid) * 2]; sa[tid] = META[(bh * 128 + tid) * 2 + 1]; }
        __syncthreads();
        if (tid < 64) {
            const int l = tid;
            const float g0 = sg[2 * l], a0 = sa[2 * l], g1 = sg[2 * l + 1], a1 = sa[2 * l + 1];
            float Gs = g0 + g1, As = fmaxf(a0 + g1, a1);
#pragma unroll
            for (int o = 1; o < 64; o <<= 1) {
                const float Gp = __shfl_up(Gs, o), Ap = __shfl_up(As, o);
                if (l >= o) { As = fmaxf(Ap + Gs, As); Gs = Gp + Gs; }
            }
            const float Ge = __shfl_up(Gs, 1), Ae = __shfl_up(As, 1);
            const float m_a = l == 0 ? 0.f : fmaxf(Ge, Ae);
            const float m_b = fmaxf(g0 + m_a, a0);
            const float m_c = fmaxf(g1 + m_b, a1);
            scl[2 * l] = __expf(g0 + m_a - m_b); sdl[2 * l] = __expf(a0 - m_b);
            scl[2 * l + 1] = __expf(g1 + m_b - m_c); sdl[2 * l + 1] = __expf(a1 - m_c);
            if (slice == 0) { MC[bh * 128 + 2 * l] = m_a; MC[bh * 128 + 2 * l + 1] = m_b; if (l == 63) p.out[O_MP + (size_t)((j * 2 + b) * 4 + h)] = m_c; }
        }
        __syncthreads();
        if (act) {
            float C[8];
#pragma unroll
            for (int k = 0; k < 8; ++k) C[k] = 0.f;
            auto step = [&](const u32x4 dv, int c) {
                u32x4 w; w.x = cvt_pk_bf16(C[0], C[1]); w.y = cvt_pk_bf16(C[2], C[3]); w.z = cvt_pk_bf16(C[4], C[5]); w.w = cvt_pk_bf16(C[6], C[7]);
                base[(size_t)c * 4096] = w;
                const float sc = scl[c], sd = sdl[c];
                const float dd[8] = {__uint_as_float(dv.x << 16), __uint_as_float(dv.x & 0xffff0000u), __uint_as_float(dv.y << 16), __uint_as_float(dv.y & 0xffff0000u),
                                     __uint_as_float(dv.z << 16), __uint_as_float(dv.z & 0xffff0000u), __uint_as_float(dv.w << 16), __uint_as_float(dv.w & 0xffff0000u)};
#pragma unroll
                for (int k = 0; k < 8; ++k) C[k] = C[k] * sc + dd[k] * sd;
            };
            for (int c0 = 0; c0 < 128; c0 += 32) {
#pragma unroll
                for (int i = 0; i < 16; ++i) d1[i] = base[(size_t)(c0 + 16 + i) * 4096];
#pragma unroll
                for (int i = 0; i < 16; ++i) step(d0[i], c0 + i);
                if (c0 + 32 < 128) {
#pragma unroll
                    for (int i = 0; i < 16; ++i) d0[i] = base[(size_t)(c0 + 32 + i) * 4096];
                }
#pragma unroll
                for (int i = 0; i < 16; ++i) step(d1[i], c0 + 16 + i);
            }
            float* co = p.out + O_CP + (size_t)((j * 2 + b) * 4 + h) * 32768 + e;
            *(f32x4*)co = (f32x4){C[0], C[1], C[2], C[3]}; *(f32x4*)(co + 4) = (f32x4){C[4], C[5], C[6], C[7]};
        }
        if (slice == 0 && tid < 128) {
            float n = 0.f;
            float* q = DN + (size_t)(bh * 128) * 128 + tid;
            for (int c0 = 0; c0 < 128; c0 += 32) {
                float d[32];
#pragma unroll
                for (int i = 0; i < 32; ++i) d[i] = q[(size_t)(c0 + i) * 128];
#pragma unroll
                for (int i = 0; i < 32; ++i) { q[(size_t)(c0 + i) * 128] = n; n = n * scl[c0 + i] + d[i] * sdl[c0 + i]; }
            }
            p.out[O_NP + (size_t)((j * 2 + b) * 4 + h) * 128 + tid] = n;
        }
        __syncthreads();
    }
}

__device__ __forceinline__ void mlstm_s3(const Params& p, int j, LAS unsigned char* lds) {
    const int tid = tid_opaque(), wv = tid >> 6, lane = tid & 63, fr = lane & 15, fq = lane >> 4;
    const u16* P = p.ACT; const u16* VT = (const u16*)((unsigned char*)p.ACT + ACT_VT_OFF);
    const u16* CC = (const u16*)(p.MLS + ML_DC); const float* NC = (const float*)(p.MLS + ML_DN); const float* MC = (const float*)(p.MLS + ML_MC);
    const float* G = (const float*)(p.MLS + ML_G);
    LAS u16* SwL = (LAS u16*)lds;
    LAS float* qnp = (LAS float*)(lds + 9216);
    LAS float* ssp = (LAS float*)(lds + 9216 + 2048);
    for (int item = blockIdx.x; item < 1024; item += gridDim.x) {
        const int bh = item >> 7, c = item & 127, b = bh >> 2, h = bh & 3;
        const int row0 = b * 8192 + c * 64;
        bf16x8 qfa[4][4], cfa[4][2], vfa[2][2];
#pragma unroll
        for (int ks = 0; ks < 4; ++ks) {
#pragma unroll
            for (int tt = 0; tt < 4; ++tt) qfa[ks][tt] = ldg8(P + (size_t)(row0 + 16 * tt + fr) * 3072 + h * 128 + 32 * ks + 8 * fq);
#pragma unroll
            for (int vt = 0; vt < 2; ++vt) cfa[ks][vt] = ldg8(CC + ((size_t)item * 256 + 32 * wv + 16 * vt + fr) * 128 + 32 * ks + 8 * fq);
        }
#pragma unroll
        for (int ks = 0; ks < 2; ++ks)
#pragma unroll
            for (int vt = 0; vt < 2; ++vt) vfa[ks][vt] = ldg8(VT + ((size_t)(bh * 256 + 32 * wv + 16 * vt + fr)) * 8192 + c * 64 + 32 * ks + 8 * fq);
        const float ipre = G[(size_t)(row0 + lane) * 8 + h] + p.b_mi[j * 4 + h];
        const float lf = logsig(G[(size_t)(row0 + lane) * 8 + 4 + h] + p.b_mf[j * 4 + h]);
        float bt = lf;
#pragma unroll
        for (int o = 1; o < 64; o <<= 1) { const float t = __shfl_up(bt, o); if (lane >= o) bt += t; }
        float cm = ipre - bt;
#pragma unroll
        for (int o = 1; o < 64; o <<= 1) { const float t = __shfl_up(cm, o); if (lane >= o) cm = fmaxf(cm, t); }
        const float mc = MC[bh * 128 + c];
        const float mt = bt + fmaxf(mc, cm);
        const float winter = __expf(bt + mc - mt);
        {
            const int tt = wv >> 1;
            const float bt_t = __shfl(bt, 16 * tt + fr), mt_t = __shfl(mt, 16 * tt + fr);
#pragma unroll
            for (int q = 0; q < 2; ++q) {
                const int st = 2 * (wv & 1) + q;
                f32x4 acc = (f32x4){0.f, 0.f, 0.f, 0.f};
                if (st <= tt) {
#pragma unroll
                    for (int ks = 0; ks < 4; ++ks) {
                        const bf16x8 kf = ldg8(P + (size_t)(row0 + 16 * st + fr) * 3072 + 512 + h * 128 + 32 * ks + 8 * fq);
                        const bf16x8 qf = tt == 0 ? qfa[ks][0] : (tt == 1 ? qfa[ks][1] : (tt == 2 ? qfa[ks][2] : qfa[ks][3]));
                        acc = MFMA16(kf, qf, acc);
                    }
                }
                float o4[4];
#pragma unroll
                for (int r = 0; r < 4; ++r) {
                    const int s = 16 * st + 4 * fq + r, t = 16 * tt + fr;
                    const float bt_s = __shfl(bt, s), ig_s = __shfl(ipre, s);
                    o4[r] = (s <= t) ? acc[r] * __expf(bt_t - bt_s + ig_s - mt_t) : 0.f;
                }
                u32x2 w; w.x = cvt_pk_bf16(o4[0], o4[1]); w.y = cvt_pk_bf16(o4[2], o4[3]);
                *(LAS u32x2*)(SwL + (16 * tt + fr) * 72 + 16 * st + 4 * fq) = w;
            }
        }
        {
            const u16* qp = P + (size_t)(row0 + lane) * 3072 + h * 128 + 16 * wv;
            const bf16x8 q0 = ldg8(qp), q1 = ldg8(qp + 8);
            const float* np = NC + (size_t)item * 128 + 16 * wv;
            float d = 0.f;
#pragma unroll
            for (int i = 0; i < 8; ++i) { d += bfs2f(q0[i]) * np[i]; d += bfs2f(q1[i]) * np[8 + i]; }
            qnp[wv * 64 + lane] = d;
        }
        __syncthreads();
        float rden;
        {
            float di = 0.f;
#pragma unroll
            for (int i = 0; i < 8; ++i) { const bf16x8 x = *(const LAS bf16x8*)(SwL + lane * 72 + 8 * i);
#pragma unroll
                for (int e = 0; e < 8; ++e) di += bfs2f(x[e]); }
            float qn = 0.f;
#pragma unroll
            for (int w8 = 0; w8 < 8; ++w8) qn += qnp[w8 * 64 + lane];
            const float den = di + winter * qn;
            rden = 1.f / fmaxf(fabsf(den), __expf(-mt));
        }
        f32x4 a1[2][4], a2[2][4];
#pragma unroll
        for (int vt = 0; vt < 2; ++vt)
#pragma unroll
            for (int tt = 0; tt < 4; ++tt) { a1[vt][tt] = (f32x4){0.f, 0.f, 0.f, 0.f}; a2[vt][tt] = (f32x4){0.f, 0.f, 0.f, 0.f}; }
#pragma unroll
        for (int ks = 0; ks < 2; ++ks) {
            bf16x8 vf[2], sf[4];
            vf[0] = vfa[ks][0]; vf[1] = vfa[ks][1];
#pragma unroll
            for (int tt = 0; tt < 4; ++tt) sf[tt] = *(const LAS bf16x8*)(SwL + (16 * tt + fr) * 72 + 32 * ks + 8 * fq);
#pragma unroll
            for (int vt = 0; vt < 2; ++vt)
#pragma unroll
                for (int tt = 0; tt < 4; ++tt) a1[vt][tt] = MFMA16(vf[vt], sf[tt], a1[vt][tt]);
        }
#pragma unroll
        for (int ks = 0; ks < 4; ++ks) {
            bf16x8 cf[2], qf[4];
            cf[0] = cfa[ks][0]; cf[1] = cfa[ks][1];
#pragma unroll
            for (int tt = 0; tt < 4; ++tt) qf[tt] = qfa[ks][tt];
#pragma unroll
            for (int vt = 0; vt < 2; ++vt)
#pragma unroll
                for (int tt = 0; tt < 4; ++tt) a2[vt][tt] = MFMA16(cf[vt], qf[tt], a2[vt][tt]);
        }
        float ssq[4];
#pragma unroll
        for (int tt = 0; tt < 4; ++tt) {
            const float wi = __shfl(winter, 16 * tt + fr), rd = __shfl(rden, 16 * tt + fr);
            float s = 0.f;
#pragma unroll
            for (int vt = 0; vt < 2; ++vt) { a1[vt][tt] = (a1[vt][tt] + a2[vt][tt] * wi) * rd;
#pragma unroll
                for (int r = 0; r < 4; ++r) s += a1[vt][tt][r] * a1[vt][tt][r]; }
            s += __shfl_xor(s, 16); s += __shfl_xor(s, 32);
            ssq[tt] = s;
        }
        if (fq == 0) {
#pragma unroll
            for (int tt = 0; tt < 4; ++tt) ssp[wv * 64 + 16 * tt + fr] = ssq[tt];
        }
        __syncthreads();
#pragma unroll
        for (int tt = 0; tt < 4; ++tt) {
            float tot = 0.f;
#pragma unroll
            for (int w8 = 0; w8 < 8; ++w8) tot += ssp[w8 * 64 + 16 * tt + fr];
            const float rs = rsqrtf(tot * (1.f / 256.f) + EPS);
#pragma unroll
            for (int vt = 0; vt < 2; ++vt) {
                const int v0 = 32 * wv + 16 * vt + 4 * fq;
                const f32x4 gh = *(const f32x4*)(p.g_head + (j * 4 + h) * 256 + v0);
                const u32x2 ou = *(const u32x2*)(P + (size_t)(row0 + 16 * tt + fr) * 3072 + 2048 + h * 256 + v0);
                const float og[4] = {__uint_as_float(ou.x << 16), __uint_as_float(ou.x & 0xffff0000u), __uint_as_float(ou.y << 16), __uint_as_float(ou.y & 0xffff0000u)};
                const f32x4 hv = a1[vt][tt];
                u32x2 w; w.x = cvt_pk_bf16(hv[0] * rs * gh[0] * og[0], hv[1] * rs * gh[1] * og[1]); w.y = cvt_pk_bf16(hv[2] * rs * gh[2] * og[2], hv[3] * rs * gh[3] * og[3]);
                *(u32x2*)(p.XN + (size_t)(row0 + 16 * tt + fr) * 1024 + h * 256 + v0) = w;
            }
        }
        __syncthreads();
    }
}

__device__ __forceinline__ void attn_phase(const Params& p, LAS unsigned char* lds) {
    const int tid = tid_opaque(), wv = tid >> 6, lane = tid & 63, fr = lane & 15, fq = lane >> 4;
    const u16* QKV = p.ACT; const u16* VTp = (const u16*)(p.MLS + SW_VTP);
    LAS u16* PL = (LAS u16*)(lds + wv * (16 * 168 * 2));
    const int gw = blockIdx.x * 8 + wv, nw = gridDim.x * 8;
    for (int it = gw; it < 16384 + 1024; it += nw) {
        const u16* qptr; const u16* Kb; const u16* Vb; size_t kstride, vstride; int kt0, nt, nkeys, qpos, kpos0; float sink; u16* optr;
        if (it < 16384) {
            const int head = it & 15, i = (it >> 4) & 511, b = it >> 13;
            const int q0 = 16 * i, kvh = head >> 2;
            qptr = QKV + (size_t)(b * 8192 + q0 + fr) * 1536 + head * 64;
            Kb = QKV + (size_t)(b * 8192) * 1536 + 1024 + kvh * 64; kstride = 1536;
            Vb = VTp + (size_t)((b * 4 + kvh) * 64) * 8192; vstride = 8192;
            const int lo = q0 - 127 < 0 ? 0 : q0 - 127;
            kt0 = lo >> 5; nt = ((q0 + 15) >> 5) - kt0 + 1; nkeys = 8192; qpos = q0 + fr; kpos0 = 0;
            sink = p.sinks[head];
            optr = p.XN + (size_t)(b * 8192 + q0 + fr) * 1024 + head * 64;
        } else {
            const int x = it - 16384, gp = x & 1, kvh = (x >> 1) & 3, b = x >> 3;
            const int head = kvh * 4 + gp * 2 + (fr >> 3), t = fr & 7;
            qptr = QKV + (size_t)(MP + b * 8 + t) * 1536 + head * 64;
            Kb = p.KS + (size_t)((b * 4 + kvh) * 160) * 64; kstride = 64;
            Vb = p.VTS + (size_t)((b * 4 + kvh) * 64) * 160; vstride = 160;
            kt0 = 0; nt = 5; nkeys = 136; qpos = 8192 + t; kpos0 = 8192 - 128;
            sink = p.sinks[head];
            optr = p.XN + (size_t)(MP + b * 8 + t) * 1024 + head * 64;
        }
        const bf16x8 qa = ldg8(qptr + 8 * fq), qb = ldg8(qptr + 32 + 8 * fq);
        f32x4 sc[5][2];
        float mx = sink;
#pragma unroll
        for (int kt = 0; kt < 5; ++kt)
#pragma unroll
            for (int sub = 0; sub < 2; ++sub) {
                f32x4 a = (f32x4){0.f, 0.f, 0.f, 0.f};
                if (kt < nt) {
                    const int key = 32 * (kt0 + kt) + 16 * sub + fr;
                    const u16* kp = Kb + (size_t)key * kstride + 8 * fq;
                    a = MFMA16(ldg8(kp), qa, a);
                    a = MFMA16(ldg8(kp + 32), qb, a);
                }
#pragma unroll
                for (int r = 0; r < 4; ++r) {
                    const int key = 32 * (kt0 + kt) + 16 * sub + 4 * fq + r;
                    const int diff = qpos - (kpos0 + key);
                    const bool ok = (kt < nt) && key < nkeys && diff >= 0 && diff < 128;
                    a[r] = ok ? a[r] : -1e30f;
                    mx = fmaxf(mx, a[r]);
                }
                sc[kt][sub] = a;
            }
        bf16x8 vfa[5][4];
#pragma unroll
        for (int kt = 0; kt < 5; ++kt)
#pragma unroll
            for (int dt = 0; dt < 4; ++dt) {
                const int ktc = kt < nt ? kt : 0;
                vfa[kt][dt] = ldg8(Vb + (size_t)(16 * dt + fr) * vstride + 32 * (kt0 + ktc) + 8 * fq);
            }
        mx = fmaxf(mx, __shfl_xor(mx, 16)); mx = fmaxf(mx, __shfl_xor(mx, 32));
        float l = 0.f;
#pragma unroll
        for (int kt = 0; kt < 5; ++kt)
#pragma unroll
            for (int sub = 0; sub < 2; ++sub) {
                float e[4];
#pragma unroll
                for (int r = 0; r < 4; ++r) { e[r] = __expf(sc[kt][sub][r] - mx); l += e[r]; }
                u32x2 w; w.x = cvt_pk_bf16(e[0], e[1]); w.y = cvt_pk_bf16(e[2], e[3]);
                *(LAS u32x2*)(PL + fr * 168 + 32 * kt + 16 * sub + 4 * fq) = w;
            }
        l += __shfl_xor(l, 16); l += __shfl_xor(l, 32);
        l += __expf(sink - mx);
        const float rl = 1.f / l;
        f32x4 o[4];
#pragma unroll
        for (int dt = 0; dt < 4; ++dt) o[dt] = (f32x4){0.f, 0.f, 0.f, 0.f};
#pragma unroll
        for (int kt = 0; kt < 5; ++kt) {
            if (kt < nt) {
                const bf16x8 pf = *(const LAS bf16x8*)(PL + fr * 168 + 32 * kt + 8 * fq);
#pragma unroll
                for (int dt = 0; dt < 4; ++dt) {
                    o[dt] = MFMA16(vfa[kt][dt], pf, o[dt]);
                }
            }
        }
#pragma unroll
        for (int dt = 0; dt < 4; ++dt) {
            u32x2 w; w.x = cvt_pk_bf16(o[dt][0] * rl, o[dt][1] * rl); w.y = cvt_pk_bf16(o[dt][2] * rl, o[dt][3] * rl);
            *(u32x2*)(optr + 16 * dt + 4 * fq) = w;
        }
    }
}

__device__ __forceinline__ void rg_conv_phase(const Params& p) {
    const u16* XB = (const u16*)(p.MLS + RG_XB); u16* U = (u16*)(p.MLS + RG_U);
    const int gt = blockIdx.x * 512 + tid_opaque(), gs = gridDim.x * 512;
    constexpr int NU = MT * 128;
    for (int i0 = gt; i0 < NU; i0 += 2 * gs) {
        bf16x8 xr[2][4]; f32x4 xc[2][4][2]; bool useb[2][4], usec[2][4]; int rr[2], cc0[2];
#pragma unroll
        for (int q = 0; q < 2; ++q) {
            const int i = (i0 + q * gs) < NU ? (i0 + q * gs) : i0;
            const int r = i >> 7, c0 = (i & 127) * 8;
            rr[q] = r; cc0[q] = c0;
            const bool prompt = r < MP;
            const int b = prompt ? (r >> 13) : ((r - MP) >> 3), t = prompt ? (r & 8191) : ((r - MP) & 7);
#pragma unroll
            for (int jj = 0; jj < 4; ++jj) {
                const int tt = t + jj - 3;
                useb[q][jj] = tt >= 0; usec[q][jj] = tt < 0 && !prompt;
                xr[q][jj] = ldg8(XB + (size_t)(tt >= 0 ? r + jj - 3 : r) * 1024 + c0);
                const float* cp = p.st_conv + ((size_t)((prompt ? 0 : b) * 3 + (tt < 0 && !prompt ? t + jj : 0))) * 1024 + c0;
                xc[q][jj][0] = *(const f32x4*)cp; xc[q][jj][1] = *(const f32x4*)(cp + 4);
            }
        }
#pragma unroll
        for (int q = 0; q < 2; ++q) {
            if (q == 1 && (i0 + gs) >= NU) break;
            const int c0 = cc0[q];
            float acc[8];
            { const f32x4 b0 = *(const f32x4*)(p.b_conv + c0), b1 = *(const f32x4*)(p.b_conv + c0 + 4);
#pragma unroll
              for (int e = 0; e < 4; ++e) { acc[e] = b0[e]; acc[4 + e] = b1[e]; } }
#pragma unroll
            for (int jj = 0; jj < 4; ++jj) {
                float xv[8];
#pragma unroll
                for (int e = 0; e < 8; ++e) xv[e] = useb[q][jj] ? bfs2f(xr[q][jj][e]) : (usec[q][jj] ? xc[q][jj][e >> 2][e & 3] : 0.f);
                const f32x4 w0 = *(const f32x4*)(p.w_conv + jj * 1024 + c0), w1 = *(const f32x4*)(p.w_conv + jj * 1024 + c0 + 4);
#pragma unroll
                for (int e = 0; e < 4; ++e) { acc[e] += w0[e] * xv[e]; acc[4 + e] += w1[e] * xv[4 + e]; }
            }
            *(bf16x8*)(U + (size_t)rr[q] * 1024 + c0) = pack8(acc);
        }
    }
}

__device__ __forceinline__ f32x2 bfpair(unsigned w) { return (f32x2){__uint_as_float(w << 16), __uint_as_float(w & 0xffff0000u)}; }
__device__ __forceinline__ void rg_scan1(const Params& p) {
    const unsigned* LA = (const unsigned*)p.ACT; const unsigned* BB = LA + (size_t)MT * 512;
    f32x2* TA = (f32x2*)(p.MLS + RG_TA); f32x2* TH = (f32x2*)(p.MLS + RG_TH);
    const int gt = blockIdx.x * 512 + tid_opaque(), gs = gridDim.x * 512;
    for (int i = gt; i < 2 * 128 * 512; i += gs) {
        const int cp = i & 511, bc = i >> 9;
        const size_t base = (size_t)bc * 64 * 512 + cp;
        f32x2 A = (f32x2){1.f, 1.f}, H = (f32x2){0.f, 0.f};
        for (int t0 = 0; t0 < 64; t0 += 16) {
            unsigned la[16], bb[16];
#pragma unroll
            for (int e = 0; e < 16; ++e) { la[e] = LA[base + (size_t)(t0 + e) * 512]; bb[e] = BB[base + (size_t)(t0 + e) * 512]; }
#pragma unroll
            for (int e = 0; e < 16; ++e) { const f32x2 l2 = bfpair(la[e]); const f32x2 a2 = (f32x2){__expf(l2[0]), __expf(l2[1])}; A *= a2; H = a2 * H + bfpair(bb[e]); }
        }
        TA[i] = A; TH[i] = H;
    }
}

__device__ __forceinline__ void rg_scan2(const Params& p) {
    const unsigned* LA = (const unsigned*)p.ACT; const unsigned* BB = LA + (size_t)MT * 512;
    const f32x2* TA = (const f32x2*)(p.MLS + RG_TA); const f32x2* TH = (const f32x2*)(p.MLS + RG_TH);
    const unsigned* GG = (const unsigned*)(p.MLS + RG_GG);
    unsigned* HY = (unsigned*)p.XN;
    const int gt = blockIdx.x * 512 + tid_opaque(), gs = gridDim.x * 512;
    for (int i = gt; i < 2 * 128 * 512 + 128 * 512; i += gs) {
        if (i < 2 * 128 * 512) {
            const int cp = i & 511, bc = i >> 9, b = bc >> 7, c = bc & 127;
            f32x2 h = (f32x2){0.f, 0.f};
            {
                const int kb = ((b * 128) << 9) + cp;
                for (int cc = 0; cc < c; cc += 16) {
                    f32x2 ta[16], th[16];
#pragma unroll
                    for (int e = 0; e < 16; ++e) { const int ci = (cc + e) < c ? (cc + e) : (c - 1); ta[e] = TA[kb + (ci << 9)]; th[e] = TH[kb + (ci << 9)]; }
#pragma unroll
                    for (int e = 0; e < 16; ++e) { const bool on = (cc + e) < c; const f32x2 a2 = on ? ta[e] : (f32x2){1.f, 1.f}; const f32x2 b2 = on ? th[e] : (f32x2){0.f, 0.f}; h = a2 * h + b2; }
                }
            }
            const size_t base = (size_t)bc * 64 * 512 + cp;
            for (int t0 = 0; t0 < 64; t0 += 16) {
                unsigned la[16], bb[16], gg[16];
#pragma unroll
                for (int e = 0; e < 16; ++e) { la[e] = LA[base + (size_t)(t0 + e) * 512]; bb[e] = BB[base + (size_t)(t0 + e) * 512]; gg[e] = GG[base + (size_t)(t0 + e) * 512]; }
#pragma unroll
                for (int e = 0; e < 16; ++e) { const f32x2 l2 = bfpair(la[e]); const f32x2 a2 = (f32x2){__expf(l2[0]), __expf(l2[1])}; h = a2 * h + bfpair(bb[e]);
                    const f32x2 g2 = bfpair(gg[e]); HY[base + (size_t)(t0 + e) * 512] = cvt_pk_bf16(h[0] * g2[0], h[1] * g2[1]); }
            }
            if (c == 127) *(f32x2*)(p.out + O_HP + (size_t)b * 1024 + 2 * cp) = h;
        } else {
            const int x = i - 2 * 128 * 512, cp = x & 511, b = x >> 9;
            f32x2 h = *(const f32x2*)(p.st_h + (size_t)b * 1024 + 2 * cp);
            const size_t base = (size_t)(MP + b * 8) * 512 + cp;
            unsigned la[8], bb[8], gg[8];
#pragma unroll
            for (int e = 0; e < 8; ++e) { la[e] = LA[base + (size_t)e * 512]; bb[e] = BB[base + (size_t)e * 512]; gg[e] = GG[base + (size_t)e * 512]; }
#pragma unroll
            for (int e = 0; e < 8; ++e) { const f32x2 l2 = bfpair(la[e]); const f32x2 a2 = (f32x2){__expf(l2[0]), __expf(l2[1])}; h = a2 * h + bfpair(bb[e]);
                const f32x2 g2 = bfpair(gg[e]); HY[base + (size_t)e * 512] = cvt_pk_bf16(h[0] * g2[0], h[1] * g2[1]); }
            *(f32x2*)(p.out + O_HS + (size_t)b * 1024 + 2 * cp) = h;
        }
    }
}

template <class Epi>
__device__ __forceinline__ void run_gemm(LAS unsigned char* lds, const u16* A, int lda, const u16* Bt, int ldb, int K, int nN, int acol, int splitk, const Epi& E) {
    pg8::Gemm g{A, Bt, lda, ldb, K};
    pg8::StaticOrder S; S.init(splitk ? 64 : MT / 256, nN, (int)gridDim.x, (int)blockIdx.x, acol, splitk, K / 64);
    pg8::gemm_phase<Epi>(lds, g, S, E);
}
__device__ __forceinline__ void idle_rank(int ntile, int& rank, int& count) {
    const int G = (int)gridDim.x, rem = ntile % G, c = (int)blockIdx.x;
    if (rem == 0) { rank = c; count = G; } else { rank = c - rem; count = G - rem; }
}
constexpr int SPLIT_OUT = 4, SPLIT_DOWN = 16;

template <bool SRES_F32>
__device__ __forceinline__ void mlp_phases(const Params& p, LAS unsigned char* lds, int layer, int sub, const float* sres, const float* pbias) {
    float* slab = (float*)(p.MLS + ML_DC);
    float* ssm = p.SS + (size_t)(2 * layer + 1) * MT;
    if (sub == 0) norm_phase<1, SPLIT_OUT, SRES_F32>(p, nullptr, ssm, sres, pbias);
    else if (sub == 1) { EpiUp E{p.ACT, ssm}; run_gemm(lds, p.X, 1024, p.wt_up + (size_t)layer * 4096 * 1024, 1024, 1024, 16, 0, 0, E);
        int rank, count; idle_rank(68 * 16, rank, count);
        if (rank >= 0) { if (layer == 0) wt_tiles<2>(p, rank, count); else if (layer == 1) wt_tiles<3>(p, rank, count); else if (layer == 2) wt_tiles<4>(p, rank, count); else cache_copy(p, rank, count); } }
    else { EpiResid<false> E{nullptr, nullptr, p.X, p.X, nullptr, slab, layer < 3 ? p.SSP : nullptr}; run_gemm(lds, p.ACT, 4096, p.wt_down + (size_t)layer * 1024 * 4096, 4096, 4096, 4, 0, SPLIT_DOWN, E); }
}

__device__ __forceinline__ void run_phase(const Params& p, int ph, LAS unsigned char* lds) {
    float* slab = (float*)(p.MLS + ML_DC);
    switch (ph) {
    case 0: wt_tiles<0>(p, (int)blockIdx.x, (int)gridDim.x); norm_phase<0, 0, false>(p, nullptr, p.SS, nullptr, nullptr); break;
    case 1: case 27: { const int j = ph == 1 ? 0 : 1;
        EpiMlstmIn E{p.ACT, (u16*)(p.MLS + ML_KT), (u16*)((unsigned char*)p.ACT + ACT_VT_OFF), (float*)(p.MLS + ML_G), p.SS + (size_t)(j == 0 ? 0 : 6) * MT};
        run_gemm(lds, p.X, 1024, p.wt_min + (size_t)j * 3328 * 1024, 1024, 1024, 13, 0, 0, E);
        if (j == 0) { int rank, count; idle_rank(68 * 13, rank, count); if (rank >= 0) { wt_tiles<1>(p, rank, count); misc_prep(p, rank, count); } } } break;
    case 2: case 28: { const int j = ph == 2 ? 0 : 1; mlstm_s1(p, j); mlstm_sample(p, j, lds); } break;
    case 3: case 29: mlstm_s2(p, ph == 3 ? 0 : 1, lds); break;
    case 4: case 30: mlstm_s3(p, ph == 4 ? 0 : 1, lds); break;
    case 5: case 31: { const int j = ph == 5 ? 0 : 1;
        if (j == 0) { EpiResid<true> E{p.xp, p.xs, nullptr, p.X, nullptr, slab, p.SSP}; run_gemm(lds, p.XN, 1024, p.wt_mout, 1024, 1024, 4, 0, SPLIT_OUT, E); }
        else { EpiResid<false> E{nullptr, nullptr, p.X, p.X, nullptr, slab, p.SSP}; run_gemm(lds, p.XN, 1024, p.wt_mout + (size_t)1024 * 1024, 1024, 1024, 4, 0, SPLIT_OUT, E); } } break;
    case 6: mlp_phases<true>(p, lds, 0, 0, p.xs, nullptr); break;
    case 7: case 8: mlp_phases<false>(p, lds, 0, ph - 6, nullptr, nullptr); break;
    case 9: norm_phase<1, SPLIT_DOWN, false>(p, nullptr, p.SS + (size_t)2 * MT, nullptr, nullptr); break;
    case 10: { EpiSwaQkv E{p.ACT, (u16*)(p.MLS + SW_VTP), p.KS, p.VTS, p.b_qkv, p.rope, p.out, p.SS + (size_t)2 * MT};
        run_gemm(lds, p.X, 1024, p.wt_qkv, 1024, 1024, 6, 0, 0, E); } break;
    case 11: attn_phase(p, lds); break;
    case 12: { EpiResid<false> E{nullptr, nullptr, p.X, p.X, p.b_sout, slab, p.SSP}; run_gemm(lds, p.XN, 1024, p.wt_sout, 1024, 1024, 4, 0, SPLIT_OUT, E); } break;
    case 13: mlp_phases<false>(p, lds, 1, 0, nullptr, p.b_sout); break;
    case 14: case 15: mlp_phases<false>(p, lds, 1, ph - 13, nullptr, nullptr); break;
    case 16: norm_phase<1, SPLIT_DOWN, false>(p, nullptr, p.SS + (size_t)4 * MT, nullptr, nullptr); break;
    case 17: { EpiRgIn E{(u16*)(p.MLS + RG_XB), (u16*)(p.MLS + RG_GG), p.out, p.SS + (size_t)4 * MT}; run_gemm(lds, p.X, 1024, p.wt_rgin, 1024, 1024, 8, 0, 0, E); } break;
    case 18: rg_conv_phase(p); break;
    case 19: { EpiRgGate E{(const u16*)(p.MLS + RG_U), p.ACT, p.ACT + (size_t)MT * 1024, p.b_a, p.b_x, p.lam};
        run_gemm(lds, (const u16*)(p.MLS + RG_U), 1024, p.wt_gate, 256, 256, 8, 512, 0, E); } break;
    case 20: rg_scan1(p); break;
    case 21: rg_scan2(p); break;
    case 22: { EpiResid<false> E{nullptr, nullptr, p.X, p.X, nullptr, slab, p.SSP}; run_gemm(lds, p.XN, 1024, p.wt_rgout, 1024, 1024, 4, 0, SPLIT_OUT, E); } break;
    case 23: mlp_phases<false>(p, lds, 2, 0, nullptr, nullptr); break;
    case 24: case 25: mlp_phases<false>(p, lds, 2, ph - 23, nullptr, nullptr); break;
    case 26: norm_phase<1, SPLIT_DOWN, false>(p, nullptr, p.SS + (size_t)6 * MT, nullptr, nullptr); break;
    case 32: mlp_phases<false>(p, lds, 3, 0, nullptr, nullptr); break;
    case 33: case 34: mlp_phases<false>(p, lds, 3, ph - 32, nullptr, nullptr); break;
    case 35: norm_phase<2, SPLIT_DOWN, false>(p, p.norm_final, nullptr, nullptr, nullptr); break;
    default: break;
    }
}

#define PROG_LIST {0,1,2,3,4,5,6,7,8,9,10,11,12,13,14,15,16,17,18,19,20,21,22,23,24,25,26,27,28,29,30,31,32,33,34,35}
constexpr int PROG[] = PROG_LIST;
constexpr int NSTEP = sizeof(PROG) / sizeof(int);
template <int I>
__device__ __forceinline__ void phase_step(const Params& p, LAS unsigned char* lds, const XcdBarrier& xb) {
    if (I >= p.p0 && I < p.p1) {
        if (I > p.p0) {
            if (I == p.p0 + 1 && p.p0 != 0) cg::this_grid().sync();
            else xcd_barrier(xb);
        }
        run_phase(p, PROG[I], lds);
    }
}
template <int... I>
__device__ __forceinline__ void run_all(const Params& p, LAS unsigned char* lds, const XcdBarrier& xb, std::integer_sequence<int, I...>) { (phase_step<I>(p, lds, xb), ...); }

constexpr int LDS_BYTES = pg8::STAGE_BYTES + 64;

__global__ void __launch_bounds__(512, 2) mk_fwd(Params p) {
    extern __shared__ __attribute__((aligned(16))) unsigned char shm[];
    LAS unsigned char* lds = (LAS unsigned char*)shm;
    volatile LAS unsigned* st = (volatile LAS unsigned*)(lds + pg8::STAGE_BYTES);
    const bool multi = (p.p1 - p.p0) > 1;
    XcdBarrier xb;
    if (multi) {
        if (threadIdx.x < 4) st[threadIdx.x] = 0u;
        __syncthreads();
        xb = xcd_barrier_post(p.bar, st);
    }
    run_all(p, lds, xb, std::make_integer_sequence<int, NSTEP>{});
}

static size_t align_up(size_t x, size_t a) { return (x + a - 1) / a * a; }

extern "C" void kernel_launch(void* const* d_in, const int* in_sizes, int n_in, void* d_out, int out_size, void* d_ws, size_t ws_size, hipStream_t stream) {
    static int grid = 0;
    if (grid == 0) {
        int dev = 0, cus = 0, per_cu = 0;
        (void)hipGetDevice(&dev);
        (void)hipDeviceGetAttribute(&cus, hipDeviceAttributeMultiprocessorCount, dev);
        if (hipFuncSetAttribute((const void*)mk_fwd, hipFuncAttributeMaxDynamicSharedMemorySize, LDS_BYTES) != hipSuccess) { fprintf(stderr, "hipFuncSetAttribute failed\n"); grid = -1; return; }
        (void)hipOccupancyMaxActiveBlocksPerMultiprocessor(&per_cu, (const void*)mk_fwd, 512, LDS_BYTES);
        (void)hipGetLastError();
        if (per_cu < 1) per_cu = 1;
        grid = cus * 1;
        if (n_in != 33 || out_size != (int)O_END) fprintf(stderr, "kernel_launch: unexpected n_in %d out_size %d\n", n_in, out_size);
    }
    if (grid < 0) return;
    Params p{};
    auto F = [&](int i) { return (const float*)d_in[i]; };
    p.xp = F(0); p.xs = F(1); p.st_c = F(2); p.st_n = F(3); p.st_m = F(4); p.ck = F(5); p.cv = F(6); p.st_h = F(7); p.st_conv = F(8);
    p.norm_mix = F(9); p.norm_mlp = F(10); p.norm_final = F(11);
    p.b_mi = F(15); p.b_mf = F(16); p.g_head = F(17); p.b_qkv = F(20); p.sinks = F(21); p.b_sout = F(23);
    p.w_conv = F(25); p.b_conv = F(26); p.b_a = F(28); p.b_x = F(30); p.lam = F(31);
    p.out = (float*)d_out;
    unsigned char* ws = (unsigned char*)d_ws; size_t off = 0;
    auto take = [&](size_t bytes) { unsigned char* r = ws + off; off = align_up(off + bytes, 256); return r; };
    p.bar = (unsigned*)take(XCD_BAR_WORDS * 4);
    p.SS = (float*)take((size_t)8 * MT * 4);
    p.SSP = (float*)take((size_t)MT * 16 * 4);
    p.rope = (f32x2*)take((size_t)8200 * 8 * 8);
    p.wt_up = (u16*)take((size_t)4 * 4096 * 1024 * 2);
    p.wt_down = (u16*)take((size_t)4 * 1024 * 4096 * 2);
    p.wt_min = (u16*)take((size_t)2 * 3328 * 1024 * 2);
    p.wt_mout = (u16*)take((size_t)2 * 1024 * 1024 * 2);
    p.wt_qkv = (u16*)take((size_t)1536 * 1024 * 2);
    p.wt_sout = (u16*)take((size_t)1024 * 1024 * 2);
    p.wt_rgin = (u16*)take((size_t)2048 * 1024 * 2);
    p.wt_rgout = (u16*)take((size_t)1024 * 1024 * 2);
    p.wt_gate = (u16*)take((size_t)2048 * 256 * 2);
    p.X = (u16*)take((size_t)MT * DM * 2);
    p.XN = (u16*)take((size_t)MT * DM * 2);
    p.ACT = (u16*)take(ACT_BYTES);
    p.MLS = take(ML_END);
    p.KS = (u16*)take((size_t)128 * 4 * 160 * 64 * 2);
    p.VTS = (u16*)take((size_t)128 * 4 * 160 * 64 * 2);
    if (off > ws_size) { fprintf(stderr, "kernel_launch: workspace too small: need %zu have %zu\n", off, ws_size); return; }
    p.w_up = F(12); p.w_down = F(13); p.w_min = F(14); p.w_mout = F(18); p.w_qkv = F(19); p.w_sout = F(22); p.w_rgin = F(24); p.w_rgout = F(32); p.w_a = F(27); p.w_x = F(29);
    (void)hipMemsetAsync(p.bar, 0, XCD_BAR_WORDS * 4, stream);
#if SINGLE_LAUNCH
    p.p0 = 0; p.p1 = NSTEP;
    void* args[] = {&p};
    hipError_t e = hipLaunchCooperativeKernel((const void*)mk_fwd, dim3(grid), dim3(512), args, LDS_BYTES, stream);
    if (e != hipSuccess) fprintf(stderr, "cooperative launch failed: %s (grid %d)\n", hipGetErrorString(e), grid);
#else
    for (int ph = 0; ph < NSTEP; ++ph) {
        p.p0 = ph; p.p1 = ph + 1;
        hipLaunchKernelGGL(mk_fwd, dim3(grid), dim3(512), LDS_BYTES, stream, p);
    }
#endif
}
```

```cpp
#include <hip/hip_runtime.h>
#include <hip/hip_cooperative_groups.h>
#include <cstdio>
#include <cstdint>
#include <utility>
namespace cg = cooperative_groups;

#ifndef SINGLE_LAUNCH
#define SINGLE_LAUNCH 1
#endif

#define LAS __attribute__((address_space(3)))
typedef unsigned short u16;
typedef short bf16x8 __attribute__((ext_vector_type(8)));
typedef float f32x4 __attribute__((ext_vector_type(4)));
typedef float f32x2 __attribute__((ext_vector_type(2)));
typedef unsigned u32x4 __attribute__((ext_vector_type(4)));
typedef unsigned u32x2 __attribute__((ext_vector_type(2)));

constexpr int MP = 16384, MS = 1024, MT = 17408, DM = 1024, SEQ = 8192;
constexpr int NPH = 36;
constexpr float EPS = 1e-6f;

__device__ __forceinline__ float bf2f(u16 b) { return __uint_as_float(((unsigned)b) << 16); }
__device__ __forceinline__ float bfs2f(short b) { return __uint_as_float(((unsigned)(u16)b) << 16); }
__device__ __forceinline__ unsigned cvt_pk_bf16(float lo, float hi) { unsigned r; asm volatile("v_cvt_pk_bf16_f32 %0, %1, %2" : "=v"(r) : "v"(lo), "v"(hi)); return r; }
__device__ __forceinline__ u16 f2bf(float f) { return (u16)(cvt_pk_bf16(f, 0.f) & 0xffffu); }
__device__ __forceinline__ float sigm(float x) { return __builtin_amdgcn_rcpf(1.f + __expf(-x)); }
__device__ __forceinline__ float logsig(float z) { return fminf(z, 0.f) - log1pf(__expf(-fabsf(z))); }
__device__ __forceinline__ float softplusf(float x) { return fmaxf(x, 0.f) + log1pf(__expf(-fabsf(x))); }
__device__ __forceinline__ bf16x8 ldg8(const u16* p) { return *(const bf16x8*)p; }
__device__ __forceinline__ bf16x8 pack8(const float* v) {
    u32x4 w; w.x = cvt_pk_bf16(v[0], v[1]); w.y = cvt_pk_bf16(v[2], v[3]); w.z = cvt_pk_bf16(v[4], v[5]); w.w = cvt_pk_bf16(v[6], v[7]);
    return __builtin_bit_cast(bf16x8, w);
}
__device__ __forceinline__ float gelu_tanh(float x) {
    const float u = 0.7978845608f * (x + 0.044715f * x * x * x);
    const float e = __expf(-2.f * fabsf(u));
    float t = (1.f - e) * __builtin_amdgcn_rcpf(1.f + e); t = u < 0.f ? -t : t;
    return 0.5f * x * (1.f + t);
}

__device__ __forceinline__ int tid_opaque() { int t; asm volatile("v_mov_b32 %0, %1" : "=v"(t) : "v"((int)threadIdx.x)); return t; }
#define XB_TMO      128
#define XB_XCNT(j)  (256  + 64 * (j))
#define XB_XSUB(j)  (1280 + 64 * (j))
#define XB_XGEN(j)  (2304 + 64 * (j))
#define XB_TOP      3328
#define XB_TOPGEN   3392
#define XCD_BAR_WORDS 3456
#define XB_SPIN_CAP (1u << 20)
__device__ __forceinline__ unsigned xb_ld(unsigned* p)              { return __hip_atomic_load(p, __ATOMIC_RELAXED, __HIP_MEMORY_SCOPE_AGENT); }
__device__ __forceinline__ unsigned xb_add(unsigned* p, unsigned v) { return __hip_atomic_fetch_add(p, v, __ATOMIC_RELAXED, __HIP_MEMORY_SCOPE_AGENT); }
__device__ __forceinline__ unsigned xb_xcc_id() { return (unsigned)__builtin_amdgcn_s_getreg((3 << 11) | 20) & 0xFu; }
#define XB_SPIN(cond, bar) do { unsigned _sp = 0; while (cond) { __builtin_amdgcn_s_sleep(1); \
    if ((++_sp & 255u) == 0u) { if (xb_ld(&(bar)[XB_TMO])) break; if (_sp > XB_SPIN_CAP) { atomicAdd(&(bar)[XB_TMO], 1u); break; } } } } while (0)
struct XcdBarrier { unsigned* bar; unsigned x; volatile LAS unsigned* st; };
__device__ __forceinline__ XcdBarrier xcd_barrier_post(unsigned* bar, volatile LAS unsigned* st) {
    XcdBarrier b; b.bar = bar; b.x = xb_xcc_id(); b.st = st;
    if (threadIdx.x == 0) (void)xb_add(&bar[XB_XCNT(b.x)], 1u);
    return b;
}
__device__ __forceinline__ void xcd_barrier_complete(unsigned* bar, unsigned x, unsigned& nloc, unsigned& nx) {
    const unsigned G = gridDim.x * gridDim.y * gridDim.z;
    unsigned sum, cnt, mine, sp = 0u;
    for (;;) {
        sum = 0u; cnt = 0u; mine = 0u;
#pragma unroll
        for (unsigned j = 0; j < 16; ++j) { const unsigned c = xb_ld(&bar[XB_XCNT(j)]); sum += c; cnt += (c > 0u) ? 1u : 0u; mine = (j == x) ? c : mine; }
        if (sum == G) break;
        __builtin_amdgcn_s_sleep(1);
        if ((++sp & 255u) == 0u) { if (xb_ld(&bar[XB_TMO])) break; if (sp > XB_SPIN_CAP) { atomicAdd(&bar[XB_TMO], 1u); break; } }
    }
    nloc = mine > 0u ? mine : 1u; nx = cnt > 0u ? cnt : 1u;
}
__device__ __forceinline__ void xcd_barrier(const XcdBarrier& b) {
    asm volatile("s_waitcnt vmcnt(0)" ::: "memory");
    __syncthreads();
    if (threadIdx.x == 0) {
        unsigned* bar = b.bar;
        __builtin_amdgcn_s_waitcnt(0);
        unsigned nloc = b.st[0], nx = b.st[1];
        if (nloc == 0u) { xcd_barrier_complete(bar, b.x, nloc, nx); b.st[0] = nloc; b.st[1] = nx; }
        const unsigned old = xb_add(&bar[XB_XSUB(b.x)], 1u);
        const unsigned gen = old / nloc;
        if (old + 1u == (gen + 1u) * nloc) {
            __builtin_amdgcn_fence(__ATOMIC_RELEASE, "agent");
            asm volatile("s_waitcnt vmcnt(0)" ::: "memory");
            const unsigned og = xb_add(&bar[XB_TOP], 1u);
            const unsigned tg = og / nx;
            if (og + 1u == (tg + 1u) * nx) xb_add(&bar[XB_TOPGEN], 1u);
            else XB_SPIN(xb_ld(&bar[XB_TOPGEN]) == tg, bar);
            __builtin_amdgcn_fence(__ATOMIC_ACQUIRE, "agent");
            xb_add(&bar[XB_XGEN(b.x)], 1u);
            asm volatile("s_waitcnt vmcnt(0)" ::: "memory");
        } else {
            XB_SPIN(xb_ld(&bar[XB_XGEN(b.x)]) == gen, bar);
            __builtin_amdgcn_fence(__ATOMIC_ACQUIRE, "agent");
            asm volatile("s_waitcnt vmcnt(0)" ::: "memory");
        }
    }
    __syncthreads();
}

constexpr int NTILES_PREP = 3008;
struct Params {
    const float *xp, *xs, *st_c, *st_n, *st_m, *ck, *cv, *st_h, *st_conv, *norm_mix, *norm_mlp, *norm_final;
    const float *b_mi, *b_mf, *g_head, *b_qkv, *sinks, *b_sout, *w_conv, *b_conv, *b_a, *b_x, *lam;
    float* out;
    unsigned* bar; float* SS; float* SSP; f32x2* rope;
    u16 *wt_up, *wt_down, *wt_min, *wt_mout, *wt_qkv, *wt_sout, *wt_rgin, *wt_rgout, *wt_gate;
    u16* X; u16* XN; u16* ACT; unsigned char* MLS; u16* KS; u16* VTS;
    const float *w_up, *w_down, *w_min, *w_mout, *w_qkv, *w_sout, *w_rgin, *w_rgout, *w_a, *w_x;
    int p0, p1;
};
constexpr size_t O_YP = 0, O_YS = 16777216, O_CP = 17825792, O_NP = 18350080, O_MP = 18352128, O_CS = 18352144, O_NS = 51906576, O_MS = 52037648,
                 O_KP = 52038672, O_VP = 52104208, O_KS = 52169744, O_VS = 56364048, O_HP = 60558352, O_CVP = 60560400, O_HS = 60566544, O_CVS = 60697616, O_END = 61090832;
constexpr size_t ML_KT = 0;
constexpr size_t ML_DC = 16777216;
constexpr size_t ML_DN = ML_DC + 134217728;
constexpr size_t ML_META = ML_DN + 524288;
constexpr size_t ML_MC = ML_META + 8192;
constexpr size_t ML_G = ML_MC + 4096;
constexpr size_t ML_END = ML_G + 557056;
constexpr size_t SW_VTP = 0;
constexpr size_t RG_XB = 0, RG_GG = 35651584, RG_U = 2 * 35651584, RG_TA = 3 * 35651584, RG_TH = RG_TA + 1048576;
constexpr size_t ACT_BYTES = (size_t)MT * 4096 * 2;
constexpr size_t ACT_VT_OFF = (size_t)MT * 3072 * 2;

__device__ __forceinline__ const float* xin_row(const Params& p, int row) { return row < MP ? p.xp + (size_t)row * DM : p.xs + (size_t)(row - MP) * DM; }

namespace pg8 {
constexpr int BM = 256, BK = 64, HALF = 128, HTB = HALF * BK * 2, STAGE_BYTES = 8 * HTB, NXCD = 8, WGM = 8;
__host__ __device__ __forceinline__ int lds_byte(int r, int c) { const int st = (r >> 4) * 2 + (c >> 5), rr = r & 15, cc = c & 31, ob = rr * 64 + cc * 2; return st * 1024 + (ob ^ (((ob >> 9) & 1) << 5)); }
__host__ __device__ __forceinline__ void stage_rc(int b, int& R, int& C) { const int st = b / 1024, sb = b % 1024, swz = sb ^ (((sb >> 9) & 1) << 5); R = (st >> 1) * 16 + swz / 64; C = (st & 1) * 32 + (swz % 64) / 2; }
__host__ __device__ __forceinline__ int perm32(int rho) { const int n = rho >> 4, i = rho & 15; return 8 * (i >> 2) + 4 * n + (i & 3); }
struct Unit { int pm, pn, kb, nt, split; };
struct Gemm { const u16* A; const u16* Bt; int lda, ldb, K; };
struct StaticOrder {
    int nM, nN, nwg, G, c, acol_bytes, splitk, ntfull;
    __device__ void init(int nM_, int nN_, int G_, int c_, int acol_, int splitk_, int ntfull_) { nM = nM_; nN = nN_; nwg = nM * nN; G = G_; c = c_; acol_bytes = acol_; splitk = splitk_; ntfull = ntfull_; }
    __device__ __forceinline__ bool next(int i, int& u_pm, int& u_pn, int& u_kb, int& u_nt, int& u_split) const {
        const long L = (long)i * G + c;
        if (L >= nwg) {
            const int e = (int)(L - nwg);
            if (splitk == 0 || e >= 16 * splitk) return false;
            const int t16 = e / splitk, ks = e - t16 * splitk;
            u_pm = nM + (t16 >> 2); u_pn = t16 & 3; u_nt = ntfull / splitk; u_kb = ks * u_nt * 128; u_split = e; return true;
        }
        int wgid = (int)L; { const int q = nwg / NXCD, r = nwg % NXCD, xcd = wgid % NXCD, off = wgid / NXCD; wgid = (xcd < r ? xcd * (q + 1) : r * (q + 1) + (xcd - r) * q) + off; }
        const int nig = WGM * nN, gid = wgid / nig, fm = gid * WGM, gsz = (nM - fm) < WGM ? (nM - fm) : WGM;
        u_pm = fm + ((wgid % nig) % gsz); u_pn = (wgid % nig) / gsz; u_kb = 0; u_nt = ntfull; u_split = -1; return true;
    }
    __device__ __forceinline__ size_t acol(int pn) const { return (size_t)(pn >> 1) * (size_t)acol_bytes; }
};

template <class Epi>
__device__ __forceinline__ void gemm_phase(LAS unsigned char* lds, const Gemm g, const StaticOrder& S, const Epi& E) {
    const int tid = tid_opaque(), wid = __builtin_amdgcn_readfirstlane(tid >> 6), lane = tid & 63, wr = wid >> 2, wc = wid & 3, fr = lane & 15, fq = lane >> 4;
    unsigned voffA[2], voffB[2];
#pragma unroll
    for (int i = 0; i < 2; ++i) { int R, C; stage_rc(tid * 16 + i * 8192, R, C); const int Rb = Epi::PERM ? ((R & ~31) + perm32(R & 31)) : R;
        voffA[i] = (unsigned)(R * g.lda + C) * 2u; voffB[i] = (unsigned)(Rb * g.ldb + C) * 2u; }
    const size_t kstep = (size_t)(BK * 2);
    const size_t hstepA = (size_t)HALF * g.lda * 2, hstepB = (size_t)HALF * g.ldb * 2;
    const size_t tstepA = 2 * hstepA, tstepB = 2 * hstepB;
    const unsigned ldsw = (unsigned)wid * 1024u;
    const int aoff = lds_byte(wr * 64 + fr, fq * 8), boff = lds_byte(wc * 32 + fr, fq * 8);
#define PG8_SA(b, h) (((b) * 2 + (h)) * HTB)
#define PG8_SB(b, h) ((4 + (b) * 2 + (h)) * HTB)
#define PG8_STAGE(bufoff, gbase, voff) do { _Pragma("unroll") for (int _i = 0; _i < 2; ++_i) \
        __builtin_amdgcn_global_load_lds((const unsigned*)((const char*)(gbase) + (voff)[_i]), (LAS unsigned*)(lds + (bufoff) + ldsw + _i * 8192), 16, 0, 0); } while (0)
#define PG8_LDA(dst, b, h) do { _Pragma("unroll") for (int m = 0; m < 4; ++m) _Pragma("unroll") for (int k = 0; k < 2; ++k) dst[m][k] = *(const LAS bf16x8*)(lds + PG8_SA(b, h) + aoff + m * 2048 + k * 1024); } while (0)
#define PG8_LDB(dst, b, h) do { _Pragma("unroll") for (int n = 0; n < 2; ++n) _Pragma("unroll") for (int k = 0; k < 2; ++k) dst[n][k] = *(const LAS bf16x8*)(lds + PG8_SB(b, h) + boff + n * 2048 + k * 1024); } while (0)
#define PG8_MMA(ai, bj, At, Bt) do { __builtin_amdgcn_s_setprio(1); _Pragma("unroll") for (int m = 0; m < 4; ++m) _Pragma("unroll") for (int n = 0; n < 2; ++n) _Pragma("unroll") for (int k = 0; k < 2; ++k) \
        acc[ai][bj][m][n] = __builtin_amdgcn_mfma_f32_16x16x32_bf16(Bt[n][k], At[m][k], acc[ai][bj][m][n], 0, 0, 0); __builtin_amdgcn_s_setprio(0); } while (0)
#define PG8_WAIT_V(n) asm volatile("s_waitcnt vmcnt(" #n ")" ::: "memory")
#define PG8_WAIT_L(n) asm volatile("s_waitcnt lgkmcnt(" #n ")" ::: "memory")
#define PG8_BAR __builtin_amdgcn_s_barrier()
#define PG8_SCHED __builtin_amdgcn_sched_barrier(0)
    int c_pm, c_pn, c_kb, c_nt, c_split, n_pm = 0, n_pn = 0, n_kb = 0, n_nt = 2, n_split = -1; int ui = 0;
    if (!S.next(0, c_pm, c_pn, c_kb, c_nt, c_split)) return;
    f32x4 acc[2][2][4][2];
#pragma unroll
    for (int a = 0; a < 2; ++a)
#pragma unroll
        for (int b = 0; b < 2; ++b)
#pragma unroll
            for (int m = 0; m < 4; ++m)
#pragma unroll
                for (int n = 0; n < 2; ++n) acc[a][b][m][n] = (f32x4){0.f, 0.f, 0.f, 0.f};
    bf16x8 At[4][2], B0[2][2], B1[2][2];
    const char* cA = (const char*)g.A + (size_t)c_pm * tstepA + S.acol(c_pn) + c_kb; const char* cB = (const char*)g.Bt + (size_t)c_pn * tstepB + c_kb;
    float pre[8];
    E.pre(c_pm, wr, fr, pre);
    PG8_STAGE(PG8_SB(0, 0), cB, voffB); PG8_STAGE(PG8_SA(0, 0), cA, voffA); PG8_STAGE(PG8_SB(0, 1), cB + hstepB, voffB); PG8_STAGE(PG8_SA(0, 1), cA + hstepA, voffA);
    if (wr == 1) PG8_BAR;
    PG8_WAIT_V(4); PG8_BAR;
    PG8_STAGE(PG8_SB(1, 0), cB + kstep, voffB); PG8_STAGE(PG8_SA(1, 0), cA + kstep, voffA); PG8_STAGE(PG8_SB(1, 1), cB + hstepB + kstep, voffB);
    PG8_WAIT_V(6); PG8_BAR;
    for (;;) {
        const bool has_next = S.next(ui + 1, n_pm, n_pn, n_kb, n_nt, n_split);
        const char* nA = has_next ? (const char*)g.A + (size_t)n_pm * tstepA + S.acol(n_pn) + n_kb : cA; const char* nB = has_next ? (const char*)g.Bt + (size_t)n_pn * tstepB + n_kb : cB;
        const int nt = c_nt;
        for (int t = 0; t < nt; t += 2) {
            const bool last = (t == nt - 2);
            const char* a1 = cA + (size_t)(t + 1) * kstep;
            const char* a2 = last ? nA : cA + (size_t)(t + 2) * kstep; const char* b2 = last ? nB : cB + (size_t)(t + 2) * kstep;
            const char* a3 = a2 + kstep; const char* b3 = b2 + kstep;
            PG8_LDB(B0, 0, 0); PG8_SCHED; PG8_LDA(At, 0, 0); PG8_STAGE(PG8_SA(1, 1), a1 + hstepA, voffA);
            PG8_WAIT_L(8); PG8_BAR; PG8_WAIT_L(0); PG8_MMA(0, 0, At, B0); PG8_BAR; PG8_SCHED;
            PG8_LDB(B1, 0, 1); PG8_STAGE(PG8_SB(0, 0), b2, voffB);
            PG8_BAR; PG8_WAIT_L(0); PG8_MMA(0, 1, At, B1); PG8_BAR;
            PG8_LDA(At, 0, 1); PG8_STAGE(PG8_SA(0, 0), a2, voffA);
            PG8_BAR; PG8_WAIT_L(0); PG8_MMA(1, 0, At, B0); PG8_BAR; PG8_SCHED;
            PG8_STAGE(PG8_SB(0, 1), b2 + hstepB, voffB);
            PG8_WAIT_V(6); PG8_BAR; PG8_MMA(1, 1, At, B1); PG8_BAR;
            PG8_LDB(B0, 1, 0); PG8_SCHED; PG8_LDA(At, 1, 0); PG8_STAGE(PG8_SA(0, 1), a2 + hstepA, voffA);
            PG8_WAIT_L(8); PG8_BAR; PG8_WAIT_L(0); PG8_MMA(0, 0, At, B0); PG8_BAR; PG8_SCHED;
            PG8_LDB(B1, 1, 1); PG8_STAGE(PG8_SB(1, 0), b3, voffB);
            PG8_BAR; PG8_WAIT_L(0); PG8_MMA(0, 1, At, B1); PG8_BAR;
            PG8_LDA(At, 1, 1); PG8_STAGE(PG8_SA(1, 0), a3, voffA);
            PG8_BAR; PG8_WAIT_L(0); PG8_MMA(1, 0, At, B0); PG8_BAR; PG8_SCHED;
            PG8_STAGE(PG8_SB(1, 1), b3 + hstepB, voffB);
            PG8_WAIT_V(6); PG8_BAR; PG8_MMA(1, 1, At, B1); PG8_BAR;
        }
        { Unit cu; cu.pm = c_pm; cu.pn = c_pn; cu.kb = c_kb; cu.nt = c_nt; cu.split = c_split; E(acc, cu, wr, wc, fr, fq, pre); }
        if (!has_next) break;
#pragma unroll
        for (int a = 0; a < 2; ++a)
#pragma unroll
            for (int b = 0; b < 2; ++b)
#pragma unroll
                for (int m = 0; m < 4; ++m)
#pragma unroll
                    for (int n = 0; n < 2; ++n) acc[a][b][m][n] = (f32x4){0.f, 0.f, 0.f, 0.f};
        c_pm = n_pm; c_pn = n_pn; c_kb = n_kb; c_nt = n_nt; c_split = n_split; cA = nA; cB = nB; ++ui;
        E.pre(c_pm, wr, fr, pre);
    }
    PG8_WAIT_V(0);
    if (wr == 0) PG8_BAR;
    PG8_BAR;
#undef PG8_SA
#undef PG8_SB
#undef PG8_STAGE
#undef PG8_LDA
#undef PG8_LDB
#undef PG8_MMA
#undef PG8_WAIT_V
#undef PG8_WAIT_L
#undef PG8_BAR
#undef PG8_SCHED
}
}
using pg8::Unit;

typedef f32x4 Acc[2][2][4][2];

template <bool RF32>
struct EpiResid {
    static constexpr bool PERM = true;
    const float* rpf; const float* rsf; const u16* rx; u16* xout; const float* bias; float* slab; float* ss;
    __device__ __forceinline__ void pre(int, int, int, float (&pv)[8]) const {
#pragma unroll
        for (int i = 0; i < 8; ++i) pv[i] = 0.f;
    }
    __device__ __forceinline__ void operator()(const Acc& acc, const Unit u, int wr, int wc, int fr, int fq, const float (&pre)[8]) const {
        if (u.split >= 0) {
            u16* sb = (u16*)slab + (size_t)u.split * 65536 + (size_t)(wr * 64 + fr) * 256 + wc * 32 + 8 * fq;
#pragma unroll
            for (int ai = 0; ai < 2; ++ai)
#pragma unroll
                for (int m = 0; m < 4; ++m)
#pragma unroll
                    for (int bj = 0; bj < 2; ++bj) {
                        const f32x4 y0 = acc[ai][bj][m][0], y1 = acc[ai][bj][m][1];
                        u32x4 w; w.x = cvt_pk_bf16(y0[0], y0[1]); w.y = cvt_pk_bf16(y0[2], y0[3]); w.z = cvt_pk_bf16(y1[0], y1[1]); w.w = cvt_pk_bf16(y1[2], y1[3]);
                        *(u32x4*)(sb + (size_t)(ai * 128 + m * 16) * 256 + bj * 128) = w;
                    }
            return;
        }
        const int row0 = u.pm * 256 + wr * 64 + fr, col0 = u.pn * 256 + wc * 32 + 8 * fq;
        f32x4 bv[2][2];
#pragma unroll
        for (int bj = 0; bj < 2; ++bj)
#pragma unroll
            for (int n = 0; n < 2; ++n) bv[bj][n] = bias ? *(const f32x4*)(bias + col0 + bj * 128 + n * 4) : (f32x4){0.f, 0.f, 0.f, 0.f};
        if (RF32) {
#pragma unroll
            for (int aim = 0; aim < 4; ++aim) {
                const int ai = aim >> 1, mh = (aim & 1) * 2;
                __builtin_amdgcn_sched_barrier(0);
                f32x4 rv[2][2][2];
#pragma unroll
                for (int mm = 0; mm < 2; ++mm) {
                    const int r = row0 + ai * 128 + (mh + mm) * 16;
                    const float* rrow = (r < MP ? rpf + (size_t)r * DM : rsf + (size_t)(r - MP) * DM) + col0;
#pragma unroll
                    for (int bj = 0; bj < 2; ++bj)
#pragma unroll
                        for (int n = 0; n < 2; ++n) rv[mm][bj][n] = *(const f32x4*)(rrow + bj * 128 + n * 4);
                }
                __builtin_amdgcn_sched_barrier(0);
#pragma unroll
                for (int mm = 0; mm < 2; ++mm) {
                    const int m = mh + mm;
                    u16* orow = xout + (size_t)(row0 + ai * 128 + m * 16) * DM + col0;
                    float sq = 0.f;
#pragma unroll
                    for (int bj = 0; bj < 2; ++bj) {
                        const f32x4 y0 = acc[ai][bj][m][0] + rv[mm][bj][0] + bv[bj][0], y1 = acc[ai][bj][m][1] + rv[mm][bj][1] + bv[bj][1];
                        sq += y0[0] * y0[0] + y0[1] * y0[1] + y0[2] * y0[2] + y0[3] * y0[3] + y1[0] * y1[0] + y1[1] * y1[1] + y1[2] * y1[2] + y1[3] * y1[3];
                        u32x4 w; w.x = cvt_pk_bf16(y0[0], y0[1]); w.y = cvt_pk_bf16(y0[2], y0[3]); w.z = cvt_pk_bf16(y1[0], y1[1]); w.w = cvt_pk_bf16(y1[2], y1[3]);
                        *(u32x4*)(orow + bj * 128) = w;
                    }
                    if (ss) { sq += __shfl_xor(sq, 16); sq += __shfl_xor(sq, 32); if (fq == 0) ss[(size_t)(row0 + ai * 128 + m * 16) * 16 + u.pn * 4 + wc] = sq; }
                }
            }
        } else {
#pragma unroll
            for (int ai = 0; ai < 2; ++ai) {
                __builtin_amdgcn_sched_barrier(0);
                u32x4 raw[4][2];
#pragma unroll
                for (int m = 0; m < 4; ++m)
#pragma unroll
                    for (int bj = 0; bj < 2; ++bj) raw[m][bj] = *(const u32x4*)(rx + (size_t)(row0 + ai * 128 + m * 16) * DM + col0 + bj * 128);
                __builtin_amdgcn_sched_barrier(0);
#pragma unroll
                for (int m = 0; m < 4; ++m) {
                    u16* orow = xout + (size_t)(row0 + ai * 128 + m * 16) * DM + col0;
                    float sq = 0.f;
#pragma unroll
                    for (int bj = 0; bj < 2; ++bj) {
                        const u32x4 w0 = raw[m][bj];
                        const f32x4 r0 = (f32x4){__uint_as_float(w0.x << 16), __uint_as_float(w0.x & 0xffff0000u), __uint_as_float(w0.y << 16), __uint_as_float(w0.y & 0xffff0000u)};
                        const f32x4 r1 = (f32x4){__uint_as_float(w0.z << 16), __uint_as_float(w0.z & 0xffff0000u), __uint_as_float(w0.w << 16), __uint_as_float(w0.w & 0xffff0000u)};
                        const f32x4 y0 = acc[ai][bj][m][0] + r0 + bv[bj][0], y1 = acc[ai][bj][m][1] + r1 + bv[bj][1];
                        sq += y0[0] * y0[0] + y0[1] * y0[1] + y0[2] * y0[2] + y0[3] * y0[3] + y1[0] * y1[0] + y1[1] * y1[1] + y1[2] * y1[2] + y1[3] * y1[3];
                        u32x4 w; w.x = cvt_pk_bf16(y0[0], y0[1]); w.y = cvt_pk_bf16(y0[2], y0[3]); w.z = cvt_pk_bf16(y1[0], y1[1]); w.w = cvt_pk_bf16(y1[2], y1[3]);
                        *(u32x4*)(orow + bj * 128) = w;
                    }
                    if (ss) { sq += __shfl_xor(sq, 16); sq += __shfl_xor(sq, 32); if (fq == 0) ss[(size_t)(row0 + ai * 128 + m * 16) * 16 + u.pn * 4 + wc] = sq; }
                }
            }
        }
    }
};

struct EpiUp {
    static constexpr bool PERM = true;
    u16* U; const float* ss;
    __device__ __forceinline__ void pre(int pm, int wr, int fr, float (&pv)[8]) const {
#pragma unroll
        for (int ai = 0; ai < 2; ++ai)
#pragma unroll
            for (int m = 0; m < 4; ++m) pv[ai * 4 + m] = ss[pm * 256 + wr * 64 + fr + ai * 128 + m * 16];
    }
    __device__ __forceinline__ void operator()(const Acc& acc, const Unit u, int wr, int wc, int fr, int fq, const float (&pre)[8]) const {
        const int row0 = u.pm * 256 + wr * 64 + fr, col0 = u.pn * 256 + wc * 32 + 8 * fq;
        float rs[2][4];
#pragma unroll
        for (int ai = 0; ai < 2; ++ai)
#pragma unroll
            for (int m = 0; m < 4; ++m) rs[ai][m] = rsqrtf(pre[ai * 4 + m] * (1.f / 1024.f) + EPS);
#pragma unroll
        for (int ai = 0; ai < 2; ++ai)
#pragma unroll
            for (int m = 0; m < 4; ++m) {
                __builtin_amdgcn_sched_barrier(0);
                u16* orow = U + (size_t)(row0 + ai * 128 + m * 16) * 4096 + col0;
#pragma unroll
                for (int bj = 0; bj < 2; ++bj) {
                    float v[8];
#pragma unroll
                    for (int i = 0; i < 4; ++i) { float a = fmaxf(acc[ai][bj][m][0][i] * rs[ai][m], 0.f), b = fmaxf(acc[ai][bj][m][1][i] * rs[ai][m], 0.f); v[i] = a * a; v[4 + i] = b * b; }
                    *(bf16x8*)(orow + bj * 128) = pack8(v);
                }
            }
    }
};

struct EpiMlstmIn {
    static constexpr bool PERM = true;
    u16* P; u16* KT; u16* VT; float* G; const float* ss;
    __device__ __forceinline__ void pre(int pm, int wr, int fr, float (&pv)[8]) const {
#pragma unroll
        for (int ai = 0; ai < 2; ++ai)
#pragma unroll
            for (int m = 0; m < 4; ++m) pv[ai * 4 + m] = ss[pm * 256 + wr * 64 + fr + ai * 128 + m * 16];
    }
    __device__ __forceinline__ void operator()(const Acc& acc, const Unit u, int wr, int wc, int fr, int fq, const float (&pre)[8]) const {
        const int row0 = u.pm * 256 + wr * 64 + fr, colt = u.pn * 256 + wc * 32 + 8 * fq;
        float rs[2][4];
#pragma unroll
        for (int ai = 0; ai < 2; ++ai)
#pragma unroll
            for (int m = 0; m < 4; ++m) rs[ai][m] = rsqrtf(pre[ai * 4 + m] * (1.f / 1024.f) + EPS);
        const int pn = u.pn;
        if (pn == 12) {
            if (wc == 0 && fq == 0) {
#pragma unroll
                for (int ai = 0; ai < 2; ++ai)
#pragma unroll
                    for (int m = 0; m < 4; ++m) {
                        float* gr = G + (size_t)(row0 + ai * 128 + m * 16) * 8;
                        *(f32x4*)gr = acc[ai][0][m][0] * rs[ai][m]; *(f32x4*)(gr + 4) = acc[ai][0][m][1] * rs[ai][m];
                    }
            }
            return;
        }
        const int kind = pn < 2 ? 0 : (pn < 4 ? 1 : (pn < 8 ? 2 : 3));
#pragma unroll
        for (int ai = 0; ai < 2; ++ai)
#pragma unroll
            for (int m = 0; m < 4; ++m) {
                __builtin_amdgcn_sched_barrier(0);
                const int r = row0 + ai * 128 + m * 16;
#pragma unroll
                for (int bj = 0; bj < 2; ++bj) {
                    const int c0 = colt + bj * 128;
                    float v[8];
#pragma unroll
                    for (int i = 0; i < 4; ++i) { v[i] = acc[ai][bj][m][0][i] * rs[ai][m]; v[4 + i] = acc[ai][bj][m][1][i] * rs[ai][m]; }
                    if (kind == 1) {
#pragma unroll
                        for (int i = 0; i < 8; ++i) v[i] *= 0.08838834764831845f;
                    } else if (kind == 3) {
#pragma unroll
                        for (int i = 0; i < 8; ++i) v[i] = sigm(v[i]);
                    }
                    const bf16x8 w = pack8(v);
                    if (!(kind == 2 && r < MP)) *(bf16x8*)(P + (size_t)r * 3072 + c0) = w;
                    if (r < MP && (kind == 1 || kind == 2)) {
                        const int b = r >> 13, s = r & 8191;
                        u16* tb = (kind == 1) ? KT + ((size_t)(b * 512 + (c0 - 512)) * 8192 + s) : VT + ((size_t)(b * 1024 + (c0 - 1024)) * 8192 + s);
#pragma unroll
                        for (int i = 0; i < 8; ++i) tb[(size_t)i * 8192] = (u16)w[i];
                    }
                }
            }
    }
};

struct EpiSwaQkv {
    static constexpr bool PERM = true;
    u16* QKV; u16* VTp; u16* KS; u16* VTS; const float* bias; const f32x2* rope; float* out; const float* ss;
    __device__ __forceinline__ void pre(int pm, int wr, int fr, float (&pv)[8]) const {
#pragma unroll
        for (int ai = 0; ai < 2; ++ai)
#pragma unroll
            for (int m = 0; m < 4; ++m) pv[ai * 4 + m] = ss[pm * 256 + wr * 64 + fr + ai * 128 + m * 16];
    }
    __device__ __forceinline__ void operator()(const Acc& acc, const Unit u, int wr, int wc, int fr, int fq, const float (&pre)[8]) const {
        const int row0 = u.pm * 256 + wr * 64 + fr, colt = u.pn * 256 + wc * 32 + 8 * fq;
        float rs[2][4];
#pragma unroll
        for (int ai = 0; ai < 2; ++ai)
#pragma unroll
            for (int m = 0; m < 4; ++m) rs[ai][m] = rsqrtf(pre[ai * 4 + m] * (1.f / 1024.f) + EPS);
        const int pn = u.pn;
        const bool ropelane = ((wc & 1) == 0) && fq < 2;
        f32x4 bb[2][2];
#pragma unroll
        for (int bj = 0; bj < 2; ++bj) { bb[bj][0] = *(const f32x4*)(bias + colt + bj * 128); bb[bj][1] = *(const f32x4*)(bias + colt + bj * 128 + 4); }
#pragma unroll
        for (int aim = 0; aim < 4; ++aim) {
            const int ai = aim >> 1, mh = (aim & 1) * 2;
            __builtin_amdgcn_sched_barrier(0);
            f32x4 csv[2][4];
            if (pn < 5) {
#pragma unroll
                for (int mm = 0; mm < 2; ++mm) {
                    const int m = mh + mm;
                    const int r = row0 + ai * 128 + m * 16;
                    const int pos = r < MP ? (r & 8191) : 8192 + ((r - MP) & 7);
                    const f32x4* rp4 = (const f32x4*)(rope + (size_t)pos * 8);
#pragma unroll
                    for (int q = 0; q < 4; ++q) csv[mm][q] = rp4[q];
                }
            }
            __builtin_amdgcn_sched_barrier(0);
#pragma unroll
            for (int mm = 0; mm < 2; ++mm) {
                const int m = mh + mm;
                const int r = row0 + ai * 128 + m * 16;
                const bool prompt = r < MP;
                const int b = prompt ? (r >> 13) : ((r - MP) >> 3);
                const int s = prompt ? (r & 8191) : ((r - MP) & 7);
                f32x2 cs[8];
                if (pn < 5) {
#pragma unroll
                    for (int q = 0; q < 4; ++q) { cs[2 * q] = (f32x2){csv[mm][q][0], csv[mm][q][1]}; cs[2 * q + 1] = (f32x2){csv[mm][q][2], csv[mm][q][3]}; }
                }
#pragma unroll
                for (int bj = 0; bj < 2; ++bj) {
                    const int c0 = colt + bj * 128;
                    float v[8];
#pragma unroll
                    for (int i = 0; i < 4; ++i) { v[i] = acc[ai][bj][m][0][i] * rs[ai][m] + bb[bj][0][i]; v[4 + i] = acc[ai][bj][m][1][i] * rs[ai][m] + bb[bj][1][i]; }
                    if (pn < 5) {
#pragma unroll
                        for (int i = 0; i < 8; ++i) {
                            const float o = __shfl_xor(v[i], 16);
                            const float rot = (fq == 0) ? v[i] * cs[i].x - o * cs[i].y : v[i] * cs[i].x + o * cs[i].y;
                            v[i] = ropelane ? rot : v[i];
                        }
                    }
                    if (pn < 4) {
#pragma unroll
                        for (int i = 0; i < 8; ++i) v[i] *= 0.125f;
                    }
                    const bf16x8 w = pack8(v);
                    if (pn < 4 || (pn == 4 && prompt)) *(bf16x8*)(QKV + (size_t)r * 1536 + c0) = w;
                    if (pn == 4) {
                        const int cc = c0 - 1024, kvh = cc >> 6, d0 = cc & 63;
                        if (prompt) {
                            if (s >= 8064) { float* o = out + O_KP + ((size_t)(b * 128 + s - 8064)) * 256 + cc; *(f32x4*)o = (f32x4){v[0], v[1], v[2], v[3]}; *(f32x4*)(o + 4) = (f32x4){v[4], v[5], v[6], v[7]}; }
                        } else {
                            *(bf16x8*)(KS + ((size_t)((b * 4 + kvh) * 160 + 128 + s)) * 64 + d0) = w;
                            float* o = out + O_KS + ((size_t)(b * 128 + 120 + s)) * 256 + cc; *(f32x4*)o = (f32x4){v[0], v[1], v[2], v[3]}; *(f32x4*)(o + 4) = (f32x4){v[4], v[5], v[6], v[7]};
                        }
                    } else if (pn == 5) {
                        const int cc = c0 - 1280, kvh = cc >> 6, d0 = cc & 63;
                        if (prompt) {
                            u16* tb = VTp + ((size_t)((b * 4 + kvh) * 64 + d0)) * 8192 + s;
#pragma unroll
                            for (int i = 0; i < 8; ++i) tb[(size_t)i * 8192] = (u16)w[i];
                            if (s >= 8064) { float* o = out + O_VP + ((size_t)(b * 128 + s - 8064)) * 256 + cc; *(f32x4*)o = (f32x4){v[0], v[1], v[2], v[3]}; *(f32x4*)(o + 4) = (f32x4){v[4], v[5], v[6], v[7]}; }
                        } else {
                            u16* tb = VTS + ((size_t)((b * 4 + kvh) * 64 + d0)) * 160 + 128 + s;
#pragma unroll
                            for (int i = 0; i < 8; ++i) tb[(size_t)i * 160] = (u16)w[i];
                            float* o = out + O_VS + ((size_t)(b * 128 + 120 + s)) * 256 + cc; *(f32x4*)o = (f32x4){v[0], v[1], v[2], v[3]}; *(f32x4*)(o + 4) = (f32x4){v[4], v[5], v[6], v[7]};
                        }
                    }
                }
            }
        }
    }
};

struct EpiRgIn {
    static constexpr bool PERM = true;
    u16* XB; u16* GG; float* out; const float* ss;
    __device__ __forceinline__ void pre(int pm, int wr, int fr, float (&pv)[8]) const {
#pragma unroll
        for (int ai = 0; ai < 2; ++ai)
#pragma unroll
            for (int m = 0; m < 4; ++m) pv[ai * 4 + m] = ss[pm * 256 + wr * 64 + fr + ai * 128 + m * 16];
    }
    __device__ __forceinline__ void operator()(const Acc& acc, const Unit u, int wr, int wc, int fr, int fq, const float (&pre)[8]) const {
        const int row0 = u.pm * 256 + wr * 64 + fr, colt = u.pn * 256 + wc * 32 + 8 * fq;
        float rs[2][4];
#pragma unroll
        for (int ai = 0; ai < 2; ++ai)
#pragma unroll
            for (int m = 0; m < 4; ++m) rs[ai][m] = rsqrtf(pre[ai * 4 + m] * (1.f / 1024.f) + EPS);
        const bool isx = u.pn < 4;
#pragma unroll
        for (int ai = 0; ai < 2; ++ai)
#pragma unroll
            for (int m = 0; m < 4; ++m) {
                __builtin_amdgcn_sched_barrier(0);
                const int r = row0 + ai * 128 + m * 16;
#pragma unroll
                for (int bj = 0; bj < 2; ++bj) {
                    const int c0 = colt + bj * 128;
                    float v[8];
#pragma unroll
                    for (int i = 0; i < 4; ++i) { v[i] = acc[ai][bj][m][0][i] * rs[ai][m]; v[4 + i] = acc[ai][bj][m][1][i] * rs[ai][m]; }
                    if (isx) {
                        *(bf16x8*)(XB + (size_t)r * 1024 + c0) = pack8(v);
                        float* o = nullptr;
                        if (r < MP) { const int b = r >> 13, s = r & 8191; if (s >= 8189) o = out + O_CVP + ((size_t)(b * 3 + s - 8189)) * 1024 + c0; }
                        else { const int b = (r - MP) >> 3, s = (r - MP) & 7; if (s >= 5) o = out + O_CVS + ((size_t)(b * 3 + s - 5)) * 1024 + c0; }
                        if (o) { *(f32x4*)o = (f32x4){v[0], v[1], v[2], v[3]}; *(f32x4*)(o + 4) = (f32x4){v[4], v[5], v[6], v[7]}; }
                    } else {
#pragma unroll
                        for (int i = 0; i < 8; ++i) v[i] = gelu_tanh(v[i]);
                        *(bf16x8*)(GG + (size_t)r * 1024 + (c0 - 1024)) = pack8(v);
                    }
                }
            }
    }
};

struct EpiRgGate {
    static constexpr bool PERM = false;
    const u16* U; u16* LA; u16* BB; const float* b_a; const float* b_x; const float* lam;
    __device__ __forceinline__ void pre(int, int, int, float (&pv)[8]) const {
#pragma unroll
        for (int i = 0; i < 8; ++i) pv[i] = 0.f;
    }
    __device__ __forceinline__ void operator()(const Acc& acc, const Unit u, int wr, int wc, int fr, int fq, const float (&pre)[8]) const {
        const int row0 = u.pm * 256 + wr * 64 + fr;
        const int chb = (u.pn >> 1) * 256 + (u.pn & 1) * 128 + wc * 32 + 4 * fq;
        u32x2 uu[2][2][4];
#pragma unroll
        for (int n = 0; n < 2; ++n)
#pragma unroll
            for (int ai = 0; ai < 2; ++ai)
#pragma unroll
                for (int m = 0; m < 4; ++m) uu[n][ai][m] = *(const u32x2*)(U + (size_t)(row0 + ai * 128 + m * 16) * 1024 + chb + n * 16);
#pragma unroll
        for (int n = 0; n < 2; ++n) {
            const int ch = chb + n * 16;
            const f32x4 ba = *(const f32x4*)(b_a + ch), bx = *(const f32x4*)(b_x + ch), lm = *(const f32x4*)(lam + ch);
            float sp[4];
#pragma unroll
            for (int i = 0; i < 4; ++i) sp[i] = -8.f * softplusf(-lm[i]);
#pragma unroll
            for (int ai = 0; ai < 2; ++ai)
#pragma unroll
                for (int m = 0; m < 4; ++m) {
                    __builtin_amdgcn_sched_barrier(0);
                    const int r = row0 + ai * 128 + m * 16;
                    const u32x2 u2 = uu[n][ai][m];
                    const float uf[4] = {__uint_as_float(u2.x << 16), __uint_as_float(u2.x & 0xffff0000u), __uint_as_float(u2.y << 16), __uint_as_float(u2.y & 0xffff0000u)};
                    f32x4 av, bv;
#pragma unroll
                    for (int i = 0; i < 4; ++i) {
                        const float rr = sigm(acc[ai][0][m][n][i] + ba[i]);
                        const float gi = sigm(acc[ai][1][m][n][i] + bx[i]);
                        const float la = sp[i] * rr;
                        const float aa = __expf(la);
                        av[i] = la;
                        bv[i] = __builtin_amdgcn_sqrtf(fmaxf(1.f - aa * aa, 0.f)) * gi * uf[i];
                    }
                    { u32x2 w; w.x = cvt_pk_bf16(av[0], av[1]); w.y = cvt_pk_bf16(av[2], av[3]); *(u32x2*)(LA + (size_t)r * 1024 + ch) = w; }
                    { u32x2 w; w.x = cvt_pk_bf16(bv[0], bv[1]); w.y = cvt_pk_bf16(bv[2], bv[3]); *(u32x2*)(BB + (size_t)r * 1024 + ch) = w; }
                }
        }
    }
};

template <int SET> __device__ __forceinline__ int wt_total() { return SET == 0 ? 208 : SET == 1 ? 576 : SET == 2 ? 672 : SET == 3 ? 768 : 784; }
template <int SET> __device__ __forceinline__ int wt_map(int v) {
    if (SET == 0) return 2048 + v;
    if (SET == 1) return v < 64 ? 2464 + v : (v < 320 ? v - 64 : 1024 + (v - 320));
    if (SET == 2) return v < 96 ? 2592 + v : (v < 160 ? 2688 + (v - 96) : (v < 416 ? 256 + (v - 160) : 1280 + (v - 416)));
    if (SET == 3) return v < 128 ? 2752 + v : (v < 192 ? 2880 + (v - 128) : (v < 256 ? 2944 + (v - 192) : (v < 512 ? 512 + (v - 256) : 1536 + (v - 512))));
    return v < 208 ? 2256 + v : (v < 272 ? 2528 + (v - 208) : (v < 528 ? 768 + (v - 272) : 1792 + (v - 528)));
}
template <int SET>
__device__ __forceinline__ void wt_tiles(const Params& p, int rank, int count) {
    const int tid = tid_opaque();
    const int wv_ = tid >> 6, ln_ = tid & 63;
    const int total = wt_total<SET>();
    for (int v0 = rank; v0 < total; v0 += 2 * count) {
        f32x4 v[2][8]; u16* dstp[2]; int dK[2]; bool dok[2];
#pragma unroll
        for (int q = 0; q < 2; ++q) {
            const int t = wt_map<SET>((v0 + q * count) < total ? (v0 + q * count) : v0);
            const float* jsrc; u16* jdst; int jK, jN, jld, lt;
            if (t < 1024) { const int l = t >> 8; jsrc = p.w_up + (size_t)l * 4194304; jdst = p.wt_up + (size_t)l * 4194304; jK = 1024; jN = 4096; jld = 4096; lt = t & 255; }
            else if (t < 2048) { const int x = t - 1024, l = x >> 8; jsrc = p.w_down + (size_t)l * 4194304; jdst = p.wt_down + (size_t)l * 4194304; jK = 4096; jN = 1024; jld = 1024; lt = x & 255; }
            else if (t < 2464) { const int x = t - 2048, l = x / 208; jsrc = p.w_min + (size_t)l * 1024 * 3080; jdst = p.wt_min + (size_t)l * 3328 * 1024; jK = 1024; jN = 3080; jld = 3080; lt = x - l * 208; }
            else if (t < 2592) { const int x = t - 2464, l = x >> 6; jsrc = p.w_mout + (size_t)l * 1048576; jdst = p.wt_mout + (size_t)l * 1048576; jK = 1024; jN = 1024; jld = 1024; lt = x & 63; }
            else if (t < 2688) { jsrc = p.w_qkv; jdst = p.wt_qkv; jK = 1024; jN = 1536; jld = 1536; lt = t - 2592; }
            else if (t < 2752) { jsrc = p.w_sout; jdst = p.wt_sout; jK = 1024; jN = 1024; jld = 1024; lt = t - 2688; }
            else if (t < 2880) { jsrc = p.w_rgin; jdst = p.wt_rgin; jK = 1024; jN = 2048; jld = 2048; lt = t - 2752; }
            else if (t < 2944) { jsrc = p.w_rgout; jdst = p.wt_rgout; jK = 1024; jN = 1024; jld = 1024; lt = t - 2880; }
            else { const int x = t - 2944, jj = x >> 2, n = jj >> 2, half = (jj >> 1) & 1, which = jj & 1;
                jsrc = (which ? p.w_x : p.w_a) + (size_t)n * 65536 + half * 128; jdst = p.wt_gate + ((size_t)(n * 2 + half) * 256 + which * 128) * 256; jK = 256; jN = 128; jld = 256; lt = x & 3; }
            const int nkt = jK >> 6, nt_ = lt / nkt, kt_ = lt - nt_ * nkt;
            const int n = nt_ * 256 + 4 * ln_, k0 = kt_ * 64 + 8 * wv_;
            const bool isgate = t >= 2944;
            const float* gk = nullptr;
            if (t < 1024) gk = p.norm_mlp + (t >> 8) * 1024;
            else if (t >= 2048 && t < 2464) gk = p.norm_mix + ((t - 2048) / 208) * 3072;
            else if (t >= 2592 && t < 2688) gk = p.norm_mix + 1024;
            else if (t >= 2752 && t < 2880) gk = p.norm_mix + 2048;
#pragma unroll
            for (int i = 0; i < 8; ++i) v[q][i] = (f32x4){0.f, 0.f, 0.f, 0.f};
            if (n < jN) {
#pragma unroll
                for (int i = 0; i < 8; ++i) v[q][i] = *(const f32x4*)(jsrc + (size_t)(k0 + i) * jld + n);
                if (gk) {
#pragma unroll
                    for (int i = 0; i < 8; ++i) v[q][i] *= gk[k0 + i];
                }
            }
            dstp[q] = jdst + (size_t)n * jK + k0; dK[q] = jK;
            dok[q] = (!isgate || n < 128) && (q == 0 || (v0 + count) < total);
        }
#pragma unroll
        for (int q = 0; q < 2; ++q) {
            if (dok[q]) {
#pragma unroll
                for (int c = 0; c < 4; ++c) {
                    const float f[8] = {v[q][0][c], v[q][1][c], v[q][2][c], v[q][3][c], v[q][4][c], v[q][5][c], v[q][6][c], v[q][7][c]};
                    *(bf16x8*)(dstp[q] + (size_t)c * dK[q]) = pack8(f);
                }
            }
        }
    }
}

__device__ __forceinline__ void misc_prep(const Params& p, int rank, int count) {
    const int tid = tid_opaque();
    const int gt = rank * 512 + tid, gs = count * 512;
    for (int i = gt; i < 8200 * 8; i += gs) {
        const int pos = i >> 3, f = i & 7;
        const float inv = powf(500000.0f, -(float)(2 * f) / 16.0f);
        const float ang = (float)pos * inv;
        p.rope[i] = (f32x2){cosf(ang), sinf(ang)};
    }
    {
        constexpr int NU = 128 * 4 * 160 * 8;
        const int nit = (NU + gs - 1) / gs;
        for (int it0 = 0; it0 < nit; it0 += 4) {
            f32x4 kv[4][2], vv[4][2];
#pragma unroll
            for (int q = 0; q < 4; ++q) {
                int i = gt + (it0 + q) * gs; i = i < NU ? i : NU - 1;
                const int d8 = i & 7, key = (i >> 3) % 160, bk = i / 1280, b = bk >> 2, kvh = bk & 3;
                const int keyc = key < 128 ? key : 0;
                const size_t src = ((size_t)(b * 128 + keyc)) * 256 + kvh * 64 + d8 * 8;
                kv[q][0] = *(const f32x4*)(p.ck + src); kv[q][1] = *(const f32x4*)(p.ck + src + 4);
                vv[q][0] = *(const f32x4*)(p.cv + src); vv[q][1] = *(const f32x4*)(p.cv + src + 4);
            }
#pragma unroll
            for (int q = 0; q < 4; ++q) {
                const int i = gt + (it0 + q) * gs;
                if (i < NU) {
                    const int d8 = i & 7, key = (i >> 3) % 160, bk = i / 1280;
                    if (key < 128 || key >= 136) {
                        const bool z = key >= 136;
                        float kf[8], vf[8];
#pragma unroll
                        for (int e = 0; e < 4; ++e) { kf[e] = z ? 0.f : kv[q][0][e]; kf[4 + e] = z ? 0.f : kv[q][1][e]; vf[e] = z ? 0.f : vv[q][0][e]; vf[4 + e] = z ? 0.f : vv[q][1][e]; }
                        *(bf16x8*)(p.KS + (size_t)i * 8) = pack8(kf);
                        const bf16x8 vw = pack8(vf);
#pragma unroll
                        for (int e = 0; e < 8; ++e) p.VTS[((size_t)bk * 64 + d8 * 8 + e) * 160 + key] = (u16)vw[e];
                    }
                }
            }
        }
    }
}

__device__ __forceinline__ void cache_copy(const Params& p, int rank, int count) {
    const int tid = tid_opaque();
    const int gt = rank * 512 + tid, gs = count * 512;
    {
        constexpr int NU = 128 * 120 * 64;
        const int nit = (NU + gs - 1) / gs;
        for (int it0 = 0; it0 < nit; it0 += 4) {
            f32x4 kv[4], vv[4];
#pragma unroll
            for (int q = 0; q < 4; ++q) {
                int i = gt + (it0 + q) * gs; i = i < NU ? i : NU - 1;
                const int q4 = i & 63, rr = (i >> 6) % 120, b = i / (120 * 64);
                const size_t so = ((size_t)(b * 128 + rr + 8)) * 256 + q4 * 4;
                kv[q] = *(const f32x4*)(p.ck + so); vv[q] = *(const f32x4*)(p.cv + so);
            }
#pragma unroll
            for (int q = 0; q < 4; ++q) {
                const int i = gt + (it0 + q) * gs;
                if (i < NU) {
                    const int q4 = i & 63, rr = (i >> 6) % 120, b = i / (120 * 64);
                    const size_t dd = ((size_t)(b * 128 + rr)) * 256 + q4 * 4;
                    *(f32x4*)(p.out + O_KS + dd) = kv[q]; *(f32x4*)(p.out + O_VS + dd) = vv[q];
                }
            }
        }
    }
}

template <int KIND, int SPLITK, bool SRES_F32>
__device__ __forceinline__ void norm_phase(const Params& p, const float* g, float* ss, const float* sres32, const float* bias) {
    const int tid = tid_opaque(); const int lane = tid & 63, wv = (blockIdx.x * 512 + tid) >> 6, nw = gridDim.x * 8;
    const float* slab = (const float*)(p.MLS + ML_DC);
    auto sumsq = [&](const f32x4 (&v)[4]) {
        float sq = 0.f;
#pragma unroll
        for (int q = 0; q < 4; ++q) sq += v[q][0] * v[q][0] + v[q][1] * v[q][1] + v[q][2] * v[q][2] + v[q][3] * v[q][3];
#pragma unroll
        for (int o = 32; o; o >>= 1) sq += __shfl_xor(sq, o);
        return sq;
    };
    auto stx = [&](int r, const f32x4 (&v)[4]) {
#pragma unroll
        for (int i = 0; i < 2; ++i) {
            u32x4 w; w.x = cvt_pk_bf16(v[2 * i][0], v[2 * i][1]); w.y = cvt_pk_bf16(v[2 * i][2], v[2 * i][3]); w.z = cvt_pk_bf16(v[2 * i + 1][0], v[2 * i + 1][1]); w.w = cvt_pk_bf16(v[2 * i + 1][2], v[2 * i + 1][3]);
            *(u32x4*)(p.X + (size_t)r * DM + lane * 8 + 512 * i) = w;
        }
    };
    auto ldx = [&](const u16* row, f32x4 (&v)[4]) {
#pragma unroll
        for (int i = 0; i < 2; ++i) {
            const u32x4 w = *(const u32x4*)(row + lane * 8 + 512 * i);
            v[2 * i] = (f32x4){__uint_as_float(w.x << 16), __uint_as_float(w.x & 0xffff0000u), __uint_as_float(w.y << 16), __uint_as_float(w.y & 0xffff0000u)};
            v[2 * i + 1] = (f32x4){__uint_as_float(w.z << 16), __uint_as_float(w.z & 0xffff0000u), __uint_as_float(w.w << 16), __uint_as_float(w.w & 0xffff0000u)};
        }
    };
    auto ldf = [&](const float* row, f32x4 (&v)[4]) {
#pragma unroll
        for (int q = 0; q < 4; ++q) v[q] = *(const f32x4*)(row + lane * 8 + 512 * (q >> 1) + 4 * (q & 1));
    };
    if (KIND == 0) {
        for (int r = wv; r < MT; r += 2 * nw) {
            const int rb = r + nw; const bool hasb = rb < MT; const int rbc = hasb ? rb : r;
            f32x4 va[4], vb[4];
            ldf(xin_row(p, r), va); ldf(xin_row(p, rbc), vb);
            stx(r, va); const float sa = sumsq(va); if (lane == 0) ss[r] = sa;
            if (hasb) { stx(rb, vb); const float sb = sumsq(vb); if (lane == 0) ss[rb] = sb; }
        }
        return;
    }
    f32x4 gv[4];
    if (KIND == 2) {
#pragma unroll
        for (int q = 0; q < 4; ++q) gv[q] = *(const f32x4*)(g + lane * 8 + 512 * (q >> 1) + 4 * (q & 1));
    }
    auto fin = [&](int r, const f32x4 (&v)[4]) {
        const float rs = rsqrtf(sumsq(v) * (1.f / 1024.f) + EPS);
#pragma unroll
        for (int q = 0; q < 4; ++q) *(f32x4*)(p.out + (size_t)r * DM + lane * 8 + 512 * (q >> 1) + 4 * (q & 1)) = v[q] * rs * gv[q];
    };
    for (int r0 = wv; r0 < MS; r0 += nw) {
        const int r = MP + r0;
        f32x4 v[4];
        if (SRES_F32) ldf(sres32 + (size_t)r0 * DM, v); else ldx(p.X + (size_t)r * DM, v);
        const int t4 = (r0 >> 8) * 4;
        const u16* slabh = (const u16*)slab;
        u32x4 part[2][SPLITK > 0 ? SPLITK : 1];
#pragma unroll
        for (int i = 0; i < 2; ++i) {
            const int col = lane * 8 + 512 * i;
            const u16* sp = slabh + (size_t)((t4 + (col >> 8)) * SPLITK) * 65536 + (size_t)(r0 & 255) * 256 + (col & 255);
#pragma unroll
            for (int k = 0; k < SPLITK; ++k) part[i][k] = *(const u32x4*)(sp + (size_t)k * 65536);
        }
#pragma unroll
        for (int i = 0; i < 2; ++i) {
            const int col = lane * 8 + 512 * i;
            if (bias) { v[2 * i] += *(const f32x4*)(bias + col); v[2 * i + 1] += *(const f32x4*)(bias + col + 4); }
#pragma unroll
            for (int k = 0; k < SPLITK; ++k) {
                const u32x4 w = part[i][k];
                v[2 * i] += (f32x4){__uint_as_float(w.x << 16), __uint_as_float(w.x & 0xffff0000u), __uint_as_float(w.y << 16), __uint_as_float(w.y & 0xffff0000u)};
                v[2 * i + 1] += (f32x4){__uint_as_float(w.z << 16), __uint_as_float(w.z & 0xffff0000u), __uint_as_float(w.w << 16), __uint_as_float(w.w & 0xffff0000u)};
            }
        }
        if (KIND == 1) { stx(r, v); const float sq = sumsq(v); if (lane == 0) ss[r] = sq; }
        else fin(r, v);
    }
    if (KIND == 1) {
        for (int r = blockIdx.x * 512 + tid; r < MP; r += gridDim.x * 512) {
            const f32x4* pp = (const f32x4*)(p.SSP + (size_t)r * 16);
            const f32x4 a0 = pp[0], a1 = pp[1], a2 = pp[2], a3 = pp[3];
            ss[r] = (((a0[0] + a0[1]) + (a0[2] + a0[3])) + ((a1[0] + a1[1]) + (a1[2] + a1[3]))) + (((a2[0] + a2[1]) + (a2[2] + a2[3])) + ((a3[0] + a3[1]) + (a3[2] + a3[3])));
        }
    }
    if (KIND == 2) {
        for (int r = wv; r < MP; r += 2 * nw) {
            const int rb = r + nw; const bool hasb = rb < MP; const int rbc = hasb ? rb : r;
            f32x4 va[4], vb[4];
            ldx(p.X + (size_t)r * DM, va); ldx(p.X + (size_t)rbc * DM, vb);
            fin(r, va);
            if (hasb) fin(rb, vb);
        }
    }
}

#define MFMA16(a, b, c) __builtin_amdgcn_mfma_f32_16x16x32_bf16(a, b, c, 0, 0, 0)

__device__ __forceinline__ void mlstm_s1(const Params& p, int j) {
    const int tid = tid_opaque(), wv = tid >> 6, lane = tid & 63, fr = lane & 15, fq = lane >> 4;
    const u16* KT = (const u16*)(p.MLS + ML_KT); const u16* VT = (const u16*)((unsigned char*)p.ACT + ACT_VT_OFF);
    u16* DC = (u16*)(p.MLS + ML_DC); float* DN = (float*)(p.MLS + ML_DN); float* META = (float*)(p.MLS + ML_META);
    const float* G = (const float*)(p.MLS + ML_G);
    for (int item = blockIdx.x; item < 1024; item += gridDim.x) {
        const int bh = item >> 7, c = item & 127, b = bh >> 2, h = bh & 3;
        const int row0 = b * 8192 + c * 64;
        bf16x8 kfa[2][8], vra[2][2];
#pragma unroll
        for (int ks = 0; ks < 2; ++ks) {
#pragma unroll
            for (int kt = 0; kt < 8; ++kt) kfa[ks][kt] = ldg8(KT + ((size_t)(bh * 128 + 16 * kt + fr)) * 8192 + c * 64 + 32 * ks + 8 * fq);
#pragma unroll
            for (int vt = 0; vt < 2; ++vt) vra[ks][vt] = ldg8(VT + ((size_t)(bh * 256 + 32 * wv + 16 * vt + fr)) * 8192 + c * 64 + 32 * ks + 8 * fq);
        }
        const u16* kp = KT + ((size_t)(bh * 128 + 16 * wv + fr)) * 8192 + c * 64 + 16 * fq;
        const bf16x8 k0 = ldg8(kp), k1 = ldg8(kp + 8);
        const float ipre = G[(size_t)(row0 + lane) * 8 + h] + p.b_mi[j * 4 + h];
        const float lf = logsig(G[(size_t)(row0 + lane) * 8 + 4 + h] + p.b_mf[j * 4 + h]);
        float bt = lf;
#pragma unroll
        for (int o = 1; o < 64; o <<= 1) { const float t = __shfl_up(bt, o); if (lane >= o) bt += t; }
        const float g = __shfl(bt, 63);
        const float a = g - bt + ipre;
        float amax = a;
#pragma unroll
        for (int o = 32; o; o >>= 1) amax = fmaxf(amax, __shfl_xor(amax, o));
        const float w = __expf(a - amax);
        f32x4 acc[8][2];
#pragma unroll
        for (int kt = 0; kt < 8; ++kt) { acc[kt][0] = (f32x4){0.f, 0.f, 0.f, 0.f}; acc[kt][1] = (f32x4){0.f, 0.f, 0.f, 0.f}; }
#pragma unroll
        for (int ks = 0; ks < 2; ++ks) {
            float ws[8];
#pragma unroll
            for (int i = 0; i < 8; ++i) ws[i] = __shfl(w, 32 * ks + 8 * fq + i);
            bf16x8 vf[2];
#pragma unroll
            for (int vt = 0; vt < 2; ++vt) {
                const bf16x8 raw = vra[ks][vt];
                float f[8];
#pragma unroll
                for (int i = 0; i < 8; ++i) f[i] = bfs2f(raw[i]) * ws[i];
                vf[vt] = pack8(f);
            }
#pragma unroll
            for (int kt = 0; kt < 8; ++kt) {
                const bf16x8 kf = kfa[ks][kt];
                acc[kt][0] = MFMA16(kf, vf[0], acc[kt][0]);
                acc[kt][1] = MFMA16(kf, vf[1], acc[kt][1]);
            }
        }
#pragma unroll
        for (int kt = 0; kt < 8; ++kt)
#pragma unroll
            for (int vt = 0; vt < 2; ++vt)
                { u32x2 w2; w2.x = cvt_pk_bf16(acc[kt][vt][0], acc[kt][vt][1]); w2.y = cvt_pk_bf16(acc[kt][vt][2], acc[kt][vt][3]);
                  *(u32x2*)(DC + ((size_t)item * 256 + 32 * wv + 16 * vt + fr) * 128 + 16 * kt + 4 * fq) = w2; }
        {
            float sacc = 0.f;
#pragma unroll
            for (int i = 0; i < 8; ++i) { sacc += __shfl(w, 16 * fq + i) * bfs2f(k0[i]); sacc += __shfl(w, 16 * fq + 8 + i) * bfs2f(k1[i]); }
            sacc += __shfl_xor(sacc, 16); sacc += __shfl_xor(sacc, 32);
            if (fq == 0) DN[(size_t)item * 128 + 16 * wv + fr] = sacc;
        }
        if (tid == 0) { META[item * 2] = g; META[item * 2 + 1] = amax; }
    }
}

__device__ __forceinline__ void mlstm_sample(const Params& p, int j, LAS unsigned char* lds) {
    const int tid = tid_opaque(), lane = tid & 63, wv = tid >> 6;
    const u16* P = p.ACT; const float* G = (const float*)(p.MLS + ML_G);
    LAS float* qs = (LAS float*)lds;
    LAS float* ks = qs + 1024;
    LAS float* vs = ks + 1024;
    LAS float* sw = vs + 2048;
    LAS float* sc = sw + 64;
    LAS float* red = sc + 64;
    LAS float* n0s = red + 64;
    LAS float* gpre = n0s + 128;
    for (int item = blockIdx.x; item < 512; item += gridDim.x) {
        const int b = item >> 2, h = item & 3;
        const int row0 = MP + b * 8;
        const size_t sidx = (size_t)((j * 128 + b) * 4 + h);
        const float* c0 = p.st_c + sidx * 32768; const float* n0 = p.st_n + sidx * 128; const float m0 = p.st_m[sidx];
        for (int i = tid; i < 1024; i += 512) { const int t = i >> 7, k = i & 127; qs[i] = bf2f(P[(size_t)(row0 + t) * 3072 + h * 128 + k]); ks[i] = bf2f(P[(size_t)(row0 + t) * 3072 + 512 + h * 128 + k]); }
        for (int i = tid; i < 2048; i += 512) { const int t = i >> 8, v = i & 255; vs[i] = bf2f(P[(size_t)(row0 + t) * 3072 + 1024 + h * 256 + v]); }
        if (tid < 128) n0s[tid] = n0[tid];
        else if (tid < 144) { const int x = tid - 128; gpre[x] = G[(size_t)(row0 + (x & 7)) * 8 + (x >> 3) * 4 + h] + (x < 8 ? p.b_mi[j * 4 + h] : p.b_mf[j * 4 + h]); }
        __syncthreads();
        if (tid == 0) {
            float bt = 0.f, m = m0, btv[8], igv[8], mtv[8];
#pragma unroll
            for (int t = 0; t < 8; ++t) {
                const float ig = gpre[t];
                const float lf = logsig(gpre[8 + t]);
                bt += lf; m = fmaxf(lf + m, ig);
                btv[t] = bt; igv[t] = ig; mtv[t] = m;
                sc[t] = bt; sc[8 + t] = ig; sc[16 + t] = m; sc[24 + t] = __expf(bt + m0 - m);
            }
            const float mnew = mtv[7];
            for (int s = 0; s < 8; ++s) sc[32 + s] = __expf(btv[7] - btv[s] + igv[s] - mnew);
            sc[40] = __expf(btv[7] + m0 - mnew);
            p.out[O_MS + sidx] = mnew;
        }
        __syncthreads();
        if (tid < 64) {
            const int t = tid >> 3, s = tid & 7;
            float r = 0.f;
            if (s <= t) { float d = 0.f; for (int k = 0; k < 128; ++k) d += qs[t * 128 + k] * ks[s * 128 + k]; r = d * __expf(sc[t] - sc[s] + sc[8 + s] - sc[16 + t]); }
            sw[tid] = r;
        } else if (tid < 72) {
            const int t = tid - 64; float d = 0.f; for (int k = 0; k < 128; ++k) d += qs[t * 128 + k] * n0s[k];
            sc[48 + t] = d;
        }
        __syncthreads();
        const int v = tid >> 1, half = tid & 1;
        float dv[8], cq[8];
#pragma unroll
        for (int s = 0; s < 8; ++s) { dv[s] = sc[32 + s] * vs[s * 256 + v]; cq[s] = 0.f; }
        const float carry = sc[40];
        float* cout = p.out + O_CS + sidx * 32768 + (size_t)v * 128 + half * 64;
        const float* cin = c0 + (size_t)v * 128 + half * 64;
#pragma unroll 8
        for (int kk = 0; kk < 16; ++kk) {
            const f32x4 cv = *(const f32x4*)(cin + kk * 4);
            f32x4 nv = cv * carry;
#pragma unroll
            for (int t = 0; t < 8; ++t) {
                const f32x4 qv = *(const LAS f32x4*)(qs + t * 128 + half * 64 + kk * 4);
                const f32x4 kv = *(const LAS f32x4*)(ks + t * 128 + half * 64 + kk * 4);
                cq[t] += cv[0] * qv[0] + cv[1] * qv[1] + cv[2] * qv[2] + cv[3] * qv[3];
                nv += kv * dv[t];
            }
            *(f32x4*)(cout + kk * 4) = nv;
        }
        if (tid < 128) {
            float nn = carry * n0s[tid];
#pragma unroll
            for (int s = 0; s < 8; ++s) nn += sc[32 + s] * ks[s * 128 + tid];
            p.out[O_NS + sidx * 128 + tid] = nn;
        }
        float hv[8], hsq[8];
#pragma unroll
        for (int t = 0; t < 8; ++t) {
            cq[t] += __shfl_xor(cq[t], 1);
            float num = 0.f, den = 0.f;
#pragma unroll
            for (int s = 0; s < 8; ++s) { const float x = sw[t * 8 + s]; num += x * vs[s * 256 + v]; den += x; }
            const float wi = sc[24 + t];
            num += wi * cq[t]; den += wi * sc[48 + t];
            hv[t] = num / fmaxf(fabsf(den), __expf(-sc[16 + t]));
            hsq[t] = half == 0 ? hv[t] * hv[t] : 0.f;
#pragma unroll
            for (int o = 32; o; o >>= 1) hsq[t] += __shfl_xor(hsq[t], o);
        }
        if (lane == 0) {
#pragma unroll
            for (int t = 0; t < 8; ++t) red[wv * 8 + t] = hsq[t];
        }
        __syncthreads();
        if (half == 0) {
            const float gh = p.g_head[(j * 4 + h) * 256 + v];
#pragma unroll
            for (int t = 0; t < 8; ++t) {
                float tot = 0.f;
#pragma unroll
                for (int w8 = 0; w8 < 8; ++w8) tot += red[w8 * 8 + t];
                const float rs = rsqrtf(tot * (1.f / 256.f) + EPS);
                const float og = bf2f(P[(size_t)(row0 + t) * 3072 + 2048 + h * 256 + v]);
                p.XN[(size_t)(row0 + t) * 1024 + h * 256 + v] = f2bf(hv[t] * rs * gh * og);
            }
        }
        __syncthreads();
    }
}

__device__ __forceinline__ void mlstm_s2(const Params& p, int j, LAS unsigned char* lds) {
    const int tid = tid_opaque();
    u16* DC = (u16*)(p.MLS + ML_DC); float* DN = (float*)(p.MLS + ML_DN); const float* META = (const float*)(p.MLS + ML_META); float* MC = (float*)(p.MLS + ML_MC);
    LAS float* sg = (LAS float*)lds; LAS float* sa = sg + 128; LAS float* scl = sa + 128; LAS float* sdl = scl + 128;
    for (int u = blockIdx.x; u < 256; u += gridDim.x) {
        const int bh = u >> 5, slice = u & 31, b = bh >> 2, h = bh & 3;
        const bool act = tid < 128;
        const size_t e = (size_t)slice * 1024 + (size_t)(tid & 127) * 8;
        u32x4* base = (u32x4*)(DC + (size_t)bh * 128 * 32768 + e);
        u32x4 d0[16], d1[16];
        if (act) {
#pragma unroll
            for (int i = 0; i < 16; ++i) d0[i] = base[(size_t)i * 4096];
        }
        if (tid < 128) { sg[tid] = META[(bh * 128 + tid) * 2]; sa[tid] = META[(bh * 128 + tid) * 2 + 1]; }
        __syncthreads();
        if (tid < 64) {
            const int l = tid;
            const float g0 = sg[2 * l], a0 = sa[2 * l], g1 = sg[2 * l + 1], a1 = sa[2 * l + 1];
            float Gs = g0 + g1, As = fmaxf(a0 + g1, a1);
#pragma unroll
            for (int o = 1; o < 64; o <<= 1) {
                const float Gp = __shfl_up(Gs, o), Ap = __shfl_up(As, o);
                if (l >= o) { As = fmaxf(Ap + Gs, As); Gs = Gp + Gs; }
            }
            const float Ge = __shfl_up(Gs, 1), Ae = __shfl_up(As, 1);
            const float m_a = l == 0 ? 0.f : fmaxf(Ge, Ae);
            const float m_b = fmaxf(g0 + m_a, a0);
            const float m_c = fmaxf(g1 + m_b, a1);
            scl[2 * l] = __expf(g0 + m_a - m_b); sdl[2 * l] = __expf(a0 - m_b);
            scl[2 * l + 1] = __expf(g1 + m_b - m_c); sdl[2 * l + 1] = __expf(a1 - m_c);
            if (slice == 0) { MC[bh * 128 + 2 * l] = m_a; MC[bh * 128 + 2 * l + 1] = m_b; if (l == 63) p.out[O_MP + (size_t)((j * 2 + b) * 4 + h)] = m_c; }
        }
        __syncthreads();
        if (act) {
            float C[8];
#pragma unroll
            for (int k = 0; k < 8; ++k) C[k] = 0.f;
            auto step = [&](const u32x4 dv, int c) {
                u32x4 w; w.x = cvt_pk_bf16(C[0], C[1]); w.y = cvt_pk_bf16(C[2], C[3]); w.z = cvt_pk_bf16(C[4], C[5]); w.w = cvt_pk_bf16(C[6], C[7]);
                base[(size_t)c * 4096] = w;
                const float sc = scl[c], sd = sdl[c];
                const float dd[8] = {__uint_as_float(dv.x << 16), __uint_as_float(dv.x & 0xffff0000u), __uint_as_float(dv.y << 16), __uint_as_float(dv.y & 0xffff0000u),
                                     __uint_as_float(dv.z << 16), __uint_as_float(dv.z & 0xffff0000u), __uint_as_float(dv.w << 16), __uint_as_float(dv.w & 0xffff0000u)};
#pragma unroll
                for (int k = 0; k < 8; ++k) C[k] = C[k] * sc + dd[k] * sd;
            };
            for (int c0 = 0; c0 < 128; c0 += 32) {
#pragma unroll
                for (int i = 0; i < 16; ++i) d1[i] = base[(size_t)(c0 + 16 + i) * 4096];
#pragma unroll
                for (int i = 0; i < 16; ++i) step(d0[i], c0 + i);
                if (c0 + 32 < 128) {
#pragma unroll
                    for (int i = 0; i < 16; ++i) d0[i] = base[(size_t)(c0 + 32 + i) * 4096];
                }
#pragma unroll
                for (int i = 0; i < 16; ++i) step(d1[i], c0 + 16 + i);
            }
            float* co = p.out + O_CP + (size_t)((j * 2 + b) * 4 + h) * 32768 + e;
            *(f32x4*)co = (f32x4){C[0], C[1], C[2], C[3]}; *(f32x4*)(co + 4) = (f32x4){C[4], C[5], C[6], C[7]};
        }
        if (slice == 0 && tid < 128) {
            float n = 0.f;
            float* q = DN + (size_t)(bh * 128) * 128 + tid;
            for (int c0 = 0; c0 < 128; c0 += 32) {
                float d[32];
#pragma unroll
                for (int i = 0; i < 32; ++i) d[i] = q[(size_t)(c0 + i) * 128];
#pragma unroll
                for (int i = 0; i < 32; ++i) { q[(size_t)(c0 + i) * 128] = n; n = n * scl[c0 + i] + d[i] * sdl[c0 + i]; }
            }
            p.out[O_NP + (size_t)((j * 2 + b) * 4 + h) * 128 + tid] = n;
        }
        __syncthreads();
    }
}

__device__ __forceinline__ void mlstm_s3(const Params& p, int j, LAS unsigned char* lds) {
    const int tid = tid_opaque(), wv = tid >> 6, lane = tid & 63, fr = lane & 15, fq = lane >> 4;
    const u16* P = p.ACT; const u16* VT = (const u16*)((unsigned char*)p.ACT + ACT_VT_OFF);
    const u16* CC = (const u16*)(p.MLS + ML_DC); const float* NC = (const float*)(p.MLS + ML_DN); const float* MC = (const float*)(p.MLS + ML_MC);
    const float* G = (const float*)(p.MLS + ML_G);
    LAS u16* SwL = (LAS u16*)lds;
    LAS float* qnp = (LAS float*)(lds + 9216);
    LAS float* ssp = (LAS float*)(lds + 9216 + 2048);
    for (int item = blockIdx.x; item < 1024; item += gridDim.x) {
        const int bh = item >> 7, c = item & 127, b = bh >> 2, h = bh & 3;
        const int row0 = b * 8192 + c * 64;
        bf16x8 qfa[4][4], cfa[4][2], vfa[2][2];
#pragma unroll
        for (int ks = 0; ks < 4; ++ks) {
#pragma unroll
            for (int tt = 0; tt < 4; ++tt) qfa[ks][tt] = ldg8(P + (size_t)(row0 + 16 * tt + fr) * 3072 + h * 128 + 32 * ks + 8 * fq);
#pragma unroll
            for (int vt = 0; vt < 2; ++vt) cfa[ks][vt] = ldg8(CC + ((size_t)item * 256 + 32 * wv + 16 * vt + fr) * 128 + 32 * ks + 8 * fq);
        }
#pragma unroll
        for (int ks = 0; ks < 2; ++ks)
#pragma unroll
            for (int vt = 0; vt < 2; ++vt) vfa[ks][vt] = ldg8(VT + ((size_t)(bh * 256 + 32 * wv + 16 * vt + fr)) * 8192 + c * 64 + 32 * ks + 8 * fq);
        const float ipre = G[(size_t)(row0 + lane) * 8 + h] + p.b_mi[j * 4 + h];
        const float lf = logsig(G[(size_t)(row0 + lane) * 8 + 4 + h] + p.b_mf[j * 4 + h]);
        float bt = lf;
#pragma unroll
        for (int o = 1; o < 64; o <<= 1) { const float t = __shfl_up(bt, o); if (lane >= o) bt += t; }
        float cm = ipre - bt;
#pragma unroll
        for (int o = 1; o < 64; o <<= 1) { const float t = __shfl_up(cm, o); if (lane >= o) cm = fmaxf(cm, t); }
        const float mc = MC[bh * 128 + c];
        const float mt = bt + fmaxf(mc, cm);
        const float winter = __expf(bt + mc - mt);
        {
            const int tt = wv >> 1;
            const float bt_t = __shfl(bt, 16 * tt + fr), mt_t = __shfl(mt, 16 * tt + fr);
#pragma unroll
            for (int q = 0; q < 2; ++q) {
                const int st = 2 * (wv & 1) + q;
                f32x4 acc = (f32x4){0.f, 0.f, 0.f, 0.f};
                if (st <= tt) {
#pragma unroll
                    for (int ks = 0; ks < 4; ++ks) {
                        const bf16x8 kf = ldg8(P + (size_t)(row0 + 16 * st + fr) * 3072 + 512 + h * 128 + 32 * ks + 8 * fq);
                        const bf16x8 qf = tt == 0 ? qfa[ks][0] : (tt == 1 ? qfa[ks][1] : (tt == 2 ? qfa[ks][2] : qfa[ks][3]));
                        acc = MFMA16(kf, qf, acc);
                    }
                }
                float o4[4];
#pragma unroll
                for (int r = 0; r < 4; ++r) {
                    const int s = 16 * st + 4 * fq + r, t = 16 * tt + fr;
                    const float bt_s = __shfl(bt, s), ig_s = __shfl(ipre, s);
                    o4[r] = (s <= t) ? acc[r] * __expf(bt_t - bt_s + ig_s - mt_t) : 0.f;
                }
                u32x2 w; w.x = cvt_pk_bf16(o4[0], o4[1]); w.y = cvt_pk_bf16(o4[2], o4[3]);
                *(LAS u32x2*)(SwL + (16 * tt + fr) * 72 + 16 * st + 4 * fq) = w;
            }
        }
        {
            const u16* qp = P + (size_t)(row0 + lane) * 3072 + h * 128 + 16 * wv;
            const bf16x8 q0 = ldg8(qp), q1 = ldg8(qp + 8);
            const float* np = NC + (size_t)item * 128 + 16 * wv;
            float d = 0.f;
#pragma unroll
            for (int i = 0; i < 8; ++i) { d += bfs2f(q0[i]) * np[i]; d += bfs2f(q1[i]) * np[8 + i]; }
            qnp[wv * 64 + lane] = d;
        }
        __syncthreads();
        float rden;
        {
            float di = 0.f;
#pragma unroll
            for (int i = 0; i < 8; ++i) { const bf16x8 x = *(const LAS bf16x8*)(SwL + lane * 72 + 8 * i);
#pragma unroll
                for (int e = 0; e < 8; ++e) di += bfs2f(x[e]); }
            float qn = 0.f;
#pragma unroll
            for (int w8 = 0; w8 < 8; ++w8) qn += qnp[w8 * 64 + lane];
            const float den = di + winter * qn;
            rden = 1.f / fmaxf(fabsf(den), __expf(-mt));
        }
        f32x4 a1[2][4], a2[2][4];
#pragma unroll
        for (int vt = 0; vt < 2; ++vt)
#pragma unroll
            for (int tt = 0; tt < 4; ++tt) { a1[vt][tt] = (f32x4){0.f, 0.f, 0.f, 0.f}; a2[vt][tt] = (f32x4){0.f, 0.f, 0.f, 0.f}; }
#pragma unroll
        for (int ks = 0; ks < 2; ++ks) {
            bf16x8 vf[2], sf[4];
            vf[0] = vfa[ks][0]; vf[1] = vfa[ks][1];
#pragma unroll
            for (int tt = 0; tt < 4; ++tt) sf[tt] = *(const LAS bf16x8*)(SwL + (16 * tt + fr) * 72 + 32 * ks + 8 * fq);
#pragma unroll
            for (int vt = 0; vt < 2; ++vt)
#pragma unroll
                for (int tt = 0; tt < 4; ++tt) a1[vt][tt] = MFMA16(vf[vt], sf[tt], a1[vt][tt]);
        }
#pragma unroll
        for (int ks = 0; ks < 4; ++ks) {
            bf16x8 cf[2], qf[4];
            cf[0] = cfa[ks][0]; cf[1] = cfa[ks][1];
#pragma unroll
            for (int tt = 0; tt < 4; ++tt) qf[tt] = qfa[ks][tt];
#pragma unroll
            for (int vt = 0; vt < 2; ++vt)
#pragma unroll
                for (int tt = 0; tt < 4; ++tt) a2[vt][tt] = MFMA16(cf[vt], qf[tt], a2[vt][tt]);
        }
        float ssq[4];
#pragma unroll
        for (int tt = 0; tt < 4; ++tt) {
            const float wi = __shfl(winter, 16 * tt + fr), rd = __shfl(rden, 16 * tt + fr);
            float s = 0.f;
#pragma unroll
            for (int vt = 0; vt < 2; ++vt) { a1[vt][tt] = (a1[vt][tt] + a2[vt][tt] * wi) * rd;
#pragma unroll
                for (int r = 0; r < 4; ++r) s += a1[vt][tt][r] * a1[vt][tt][r]; }
            s += __shfl_xor(s, 16); s += __shfl_xor(s, 32);
            ssq[tt] = s;
        }
        if (fq == 0) {
#pragma unroll
            for (int tt = 0; tt < 4; ++tt) ssp[wv * 64 + 16 * tt + fr] = ssq[tt];
        }
        __syncthreads();
#pragma unroll
        for (int tt = 0; tt < 4; ++tt) {
            float tot = 0.f;
#pragma unroll
            for (int w8 = 0; w8 < 8; ++w8) tot += ssp[w8 * 64 + 16 * tt + fr];
            const float rs = rsqrtf(tot * (1.f / 256.f) + EPS);
#pragma unroll
            for (int vt = 0; vt < 2; ++vt) {
                const int v0 = 32 * wv + 16 * vt + 4 * fq;
                const f32x4 gh = *(const f32x4*)(p.g_head + (j * 4 + h) * 256 + v0);
                const u32x2 ou = *(const u32x2*)(P + (size_t)(row0 + 16 * tt + fr) * 3072 + 2048 + h * 256 + v0);
                const float og[4] = {__uint_as_float(ou.x << 16), __uint_as_float(ou.x & 0xffff0000u), __uint_as_float(ou.y << 16), __uint_as_float(ou.y & 0xffff0000u)};
                const f32x4 hv = a1[vt][tt];
                u32x2 w; w.x = cvt_pk_bf16(hv[0] * rs * gh[0] * og[0], hv[1] * rs * gh[1] * og[1]); w.y = cvt_pk_bf16(hv[2] * rs * gh[2] * og[2], hv[3] * rs * gh[3] * og[3]);
                *(u32x2*)(p.XN + (size_t)(row0 + 16 * tt + fr) * 1024 + h * 256 + v0) = w;
            }
        }
        __syncthreads();
    }
}

__device__ __forceinline__ void attn_phase(const Params& p, LAS unsigned char* lds) {
    const int tid = tid_opaque(), wv = tid >> 6, lane = tid & 63, fr = lane & 15, fq = lane >> 4;
    const u16* QKV = p.ACT; const u16* VTp = (const u16*)(p.MLS + SW_VTP);
    LAS u16* PL = (LAS u16*)(lds + wv * (16 * 168 * 2));
    const int gw = blockIdx.x * 8 + wv, nw = gridDim.x * 8;
    for (int it = gw; it < 16384 + 1024; it += nw) {
        const u16* qptr; const u16* Kb; const u16* Vb; size_t kstride, vstride; int kt0, nt, nkeys, qpos, kpos0; float sink; u16* optr;
        if (it < 16384) {
            const int head = it & 15, i = (it >> 4) & 511, b = it >> 13;
            const int q0 = 16 * i, kvh = head >> 2;
            qptr = QKV + (size_t)(b * 8192 + q0 + fr) * 1536 + head * 64;
            Kb = QKV + (size_t)(b * 8192) * 1536 + 1024 + kvh * 64; kstride = 1536;
            Vb = VTp + (size_t)((b * 4 + kvh) * 64) * 8192; vstride = 8192;
            const int lo = q0 - 127 < 0 ? 0 : q0 - 127;
            kt0 = lo >> 5; nt = ((q0 + 15) >> 5) - kt0 + 1; nkeys = 8192; qpos = q0 + fr; kpos0 = 0;
            sink = p.sinks[head];
            optr = p.XN + (size_t)(b * 8192 + q0 + fr) * 1024 + head * 64;
        } else {
            const int x = it - 16384, gp = x & 1, kvh = (x >> 1) & 3, b = x >> 3;
            const int head = kvh * 4 + gp * 2 + (fr >> 3), t = fr & 7;
            qptr = QKV + (size_t)(MP + b * 8 + t) * 1536 + head * 64;
            Kb = p.KS + (size_t)((b * 4 + kvh) * 160) * 64; kstride = 64;
            Vb = p.VTS + (size_t)((b * 4 + kvh) * 64) * 160; vstride = 160;
            kt0 = 0; nt = 5; nkeys = 136; qpos = 8192 + t; kpos0 = 8192 - 128;
            sink = p.sinks[head];
            optr = p.XN + (size_t)(MP + b * 8 + t) * 1024 + head * 64;
        }
        const bf16x8 qa = ldg8(qptr + 8 * fq), qb = ldg8(qptr + 32 + 8 * fq);
        f32x4 sc[5][2];
        float mx = sink;
#pragma unroll
        for (int kt = 0; kt < 5; ++kt)
#pragma unroll
            for (int sub = 0; sub < 2; ++sub) {
                f32x4 a = (f32x4){0.f, 0.f, 0.f, 0.f};
                if (kt < nt) {
                    const int key = 32 * (kt0 + kt) + 16 * sub + fr;
                    const u16* kp = Kb + (size_t)key * kstride + 8 * fq;
                    a = MFMA16(ldg8(kp), qa, a);
                    a = MFMA16(ldg8(kp + 32), qb, a);
                }
#pragma unroll
                for (int r = 0; r < 4; ++r) {
                    const int key = 32 * (kt0 + kt) + 16 * sub + 4 * fq + r;
                    const int diff = qpos - (kpos0 + key);
                    const bool ok = (kt < nt) && key < nkeys && diff >= 0 && diff < 128;
                    a[r] = ok ? a[r] : -1e30f;
                    mx = fmaxf(mx, a[r]);
                }
                sc[kt][sub] = a;
            }
        bf16x8 vfa[5][4];
#pragma unroll
        for (int kt = 0; kt < 5; ++kt)
#pragma unroll
            for (int dt = 0; dt < 4; ++dt) {
                const int ktc = kt < nt ? kt : 0;
                vfa[kt][dt] = ldg8(Vb + (size_t)(16 * dt + fr) * vstride + 32 * (kt0 + ktc) + 8 * fq);
            }
        mx = fmaxf(mx, __shfl_xor(mx, 16)); mx = fmaxf(mx, __shfl_xor(mx, 32));
        float l = 0.f;
#pragma unroll
        for (int kt = 0; kt < 5; ++kt)
#pragma unroll
            for (int sub = 0; sub < 2; ++sub) {
                float e[4];
#pragma unroll
                for (int r = 0; r < 4; ++r) { e[r] = __expf(sc[kt][sub][r] - mx); l += e[r]; }
                u32x2 w; w.x = cvt_pk_bf16(e[0], e[1]); w.y = cvt_pk_bf16(e[2], e[3]);
                *(LAS u32x2*)(PL + fr * 168 + 32 * kt + 16 * sub + 4 * fq) = w;
            }
        l += __shfl_xor(l, 16); l += __shfl_xor(l, 32);
        l += __expf(sink - mx);
        const float rl = 1.f / l;
        f32x4 o[4];
#pragma unroll
        for (int dt = 0; dt < 4; ++dt) o[dt] = (f32x4){0.f, 0.f, 0.f, 0.f};
#pragma unroll
        for (int kt = 0; kt < 5; ++kt) {
            if (kt < nt) {
                const bf16x8 pf = *(const LAS bf16x8*)(PL + fr * 168 + 32 * kt + 8 * fq);
#pragma unroll
                for (int dt = 0; dt < 4; ++dt) {
                    o[dt] = MFMA16(vfa[kt][dt], pf, o[dt]);
                }
            }
        }
#pragma unroll
        for (int dt = 0; dt < 4; ++dt) {
            u32x2 w; w.x = cvt_pk_bf16(o[dt][0] * rl, o[dt][1] * rl); w.y = cvt_pk_bf16(o[dt][2] * rl, o[dt][3] * rl);
            *(u32x2*)(optr + 16 * dt + 4 * fq) = w;
        }
    }
}

__device__ __forceinline__ void rg_conv_phase(const Params& p) {
    const u16* XB = (const u16*)(p.MLS + RG_XB); u16* U = (u16*)(p.MLS + RG_U);
    const int gt = blockIdx.x * 512 + tid_opaque(), gs = gridDim.x * 512;
    constexpr int NU = MT * 128;
    for (int i0 = gt; i0 < NU; i0 += 2 * gs) {
        bf16x8 xr[2][4]; f32x4 xc[2][4][2]; bool useb[2][4], usec[2][4]; int rr[2], cc0[2];
#pragma unroll
        for (int q = 0; q < 2; ++q) {
            const int i = (i0 + q * gs) < NU ? (i0 + q * gs) : i0;
            const int r = i >> 7, c0 = (i & 127) * 8;
            rr[q] = r; cc0[q] = c0;
            const bool prompt = r < MP;
            const int b = prompt ? (r >> 13) : ((r - MP) >> 3), t = prompt ? (r & 8191) : ((r - MP) & 7);
#pragma unroll
            for (int jj = 0; jj < 4; ++jj) {
                const int tt = t + jj - 3;
                useb[q][jj] = tt >= 0; usec[q][jj] = tt < 0 && !prompt;
                xr[q][jj] = ldg8(XB + (size_t)(tt >= 0 ? r + jj - 3 : r) * 1024 + c0);
                const float* cp = p.st_conv + ((size_t)((prompt ? 0 : b) * 3 + (tt < 0 && !prompt ? t + jj : 0))) * 1024 + c0;
                xc[q][jj][0] = *(const f32x4*)cp; xc[q][jj][1] = *(const f32x4*)(cp + 4);
            }
        }
#pragma unroll
        for (int q = 0; q < 2; ++q) {
            if (q == 1 && (i0 + gs) >= NU) break;
            const int c0 = cc0[q];
            float acc[8];
            { const f32x4 b0 = *(const f32x4*)(p.b_conv + c0), b1 = *(const f32x4*)(p.b_conv + c0 + 4);
#pragma unroll
              for (int e = 0; e < 4; ++e) { acc[e] = b0[e]; acc[4 + e] = b1[e]; } }
#pragma unroll
            for (int jj = 0; jj < 4; ++jj) {
                float xv[8];
#pragma unroll
                for (int e = 0; e < 8; ++e) xv[e] = useb[q][jj] ? bfs2f(xr[q][jj][e]) : (usec[q][jj] ? xc[q][jj][e >> 2][e & 3] : 0.f);
                const f32x4 w0 = *(const f32x4*)(p.w_conv + jj * 1024 + c0), w1 = *(const f32x4*)(p.w_conv + jj * 1024 + c0 + 4);
#pragma unroll
                for (int e = 0; e < 4; ++e) { acc[e] += w0[e] * xv[e]; acc[4 + e] += w1[e] * xv[4 + e]; }
            }
            *(bf16x8*)(U + (size_t)rr[q] * 1024 + c0) = pack8(acc);
        }
    }
}

__device__ __forceinline__ f32x2 bfpair(unsigned w) { return (f32x2){__uint_as_float(w << 16), __uint_as_float(w & 0xffff0000u)}; }
__device__ __forceinline__ void rg_scan1(const Params& p) {
    const unsigned* LA = (const unsigned*)p.ACT; const unsigned* BB = LA + (size_t)MT * 512;
    f32x2* TA = (f32x2*)(p.MLS + RG_TA); f32x2* TH = (f32x2*)(p.MLS + RG_TH);
    const int gt = blockIdx.x * 512 + tid_opaque(), gs = gridDim.x * 512;
    for (int i = gt; i < 2 * 128 * 512; i += gs) {
        const int cp = i & 511, bc = i >> 9;
        const size_t base = (size_t)bc * 64 * 512 + cp;
        f32x2 A = (f32x2){1.f, 1.f}, H = (f32x2){0.f, 0.f};
        for (int t0 = 0; t0 < 64; t0 += 16) {
            unsigned la[16], bb[16];
#pragma unroll
            for (int e = 0; e < 16; ++e) { la[e] = LA[base + (size_t)(t0 + e) * 512]; bb[e] = BB[base + (size_t)(t0 + e) * 512]; }
#pragma unroll
            for (int e = 0; e < 16; ++e) { const f32x2 l2 = bfpair(la[e]); const f32x2 a2 = (f32x2){__expf(l2[0]), __expf(l2[1])}; A *= a2; H = a2 * H + bfpair(bb[e]); }
        }
        TA[i] = A; TH[i] = H;
    }
}

__device__ __forceinline__ void rg_scan2(const Params& p) {
    const unsigned* LA = (const unsigned*)p.ACT; const unsigned* BB = LA + (size_t)MT * 512;
    const f32x2* TA = (const f32x2*)(p.MLS + RG_TA); const f32x2* TH = (const f32x2*)(p.MLS + RG_TH);
    const unsigned* GG = (const unsigned*)(p.MLS + RG_GG);
    unsigned* HY = (unsigned*)p.XN;
    const int gt = blockIdx.x * 512 + tid_opaque(), gs = gridDim.x * 512;
    for (int i = gt; i < 2 * 128 * 512 + 128 * 512; i += gs) {
        if (i < 2 * 128 * 512) {
            const int cp = i & 511, bc = i >> 9, b = bc >> 7, c = bc & 127;
            f32x2 h = (f32x2){0.f, 0.f};
            {
                const int kb = ((b * 128) << 9) + cp;
                int cc = 0;
                for (; cc + 8 <= c; cc += 8) {
                    f32x2 ta[8], th[8];
#pragma unroll
                    for (int e = 0; e < 8; ++e) { ta[e] = TA[kb + ((cc + e) << 9)]; th[e] = TH[kb + ((cc + e) << 9)]; }
#pragma unroll
                    for (int e = 0; e < 8; ++e) h = ta[e] * h + th[e];
                }
                for (; cc < c; ++cc) h = TA[kb + (cc << 9)] * h + TH[kb + (cc << 9)];
            }
            const size_t base = (size_t)bc * 64 * 512 + cp;
            for (int t0 = 0; t0 < 64; t0 += 16) {
                unsigned la[16], bb[16], gg[16];
#pragma unroll
                for (int e = 0; e < 16; ++e) { la[e] = LA[base + (size_t)(t0 + e) * 512]; bb[e] = BB[base + (size_t)(t0 + e) * 512]; gg[e] = GG[base + (size_t)(t0 + e) * 512]; }
#pragma unroll
                for (int e = 0; e < 16; ++e) { const f32x2 l2 = bfpair(la[e]); const f32x2 a2 = (f32x2){__expf(l2[0]), __expf(l2[1])}; h = a2 * h + bfpair(bb[e]);
                    const f32x2 g2 = bfpair(gg[e]); HY[base + (size_t)(t0 + e) * 512] = cvt_pk_bf16(h[0] * g2[0], h[1] * g2[1]); }
            }
            if (c == 127) *(f32x2*)(p.out + O_HP + (size_t)b * 1024 + 2 * cp) = h;
        } else {
            const int x = i - 2 * 128 * 512, cp = x & 511, b = x >> 9;
            f32x2 h = *(const f32x2*)(p.st_h + (size_t)b * 1024 + 2 * cp);
            const size_t base = (size_t)(MP + b * 8) * 512 + cp;
            unsigned la[8], bb[8], gg[8];
#pragma unroll
            for (int e = 0; e < 8; ++e) { la[e] = LA[base + (size_t)e * 512]; bb[e] = BB[base + (size_t)e * 512]; gg[e] = GG[base + (size_t)e * 512]; }
#pragma unroll
            for (int e = 0; e < 8; ++e) { const f32x2 l2 = bfpair(la[e]); const f32x2 a2 = (f32x2){__expf(l2[0]), __expf(l2[1])}; h = a2 * h + bfpair(bb[e]);
                const f32x2 g2 = bfpair(gg[e]); HY[base + (size_t)e * 512] = cvt_pk_bf16(h[0] * g2[0], h[1] * g2[1]); }
            *(f32x2*)(p.out + O_HS + (size_t)b * 1024 + 2 * cp) = h;
        }
    }
}

template <class Epi>
__device__ __forceinline__ void run_gemm(LAS unsigned char* lds, const u16* A, int lda, const u16* Bt, int ldb, int K, int nN, int acol, int splitk, const Epi& E) {
    pg8::Gemm g{A, Bt, lda, ldb, K};
    pg8::StaticOrder S; S.init(splitk ? 64 : MT / 256, nN, (int)gridDim.x, (int)blockIdx.x, acol, splitk, K / 64);
    pg8::gemm_phase<Epi>(lds, g, S, E);
}
__device__ __forceinline__ void idle_rank(int ntile, int& rank, int& count) {
    const int G = (int)gridDim.x, rem = ntile % G, c = (int)blockIdx.x;
    if (rem == 0) { rank = c; count = G; } else { rank = c - rem; count = G - rem; }
}
constexpr int SPLIT_OUT = 4, SPLIT_DOWN = 16;

template <bool SRES_F32>
__device__ __forceinline__ void mlp_phases(const Params& p, LAS unsigned char* lds, int layer, int sub, const float* sres, const float* pbias) {
    float* slab = (float*)(p.MLS + ML_DC);
    float* ssm = p.SS + (size_t)(2 * layer + 1) * MT;
    if (sub == 0) norm_phase<1, SPLIT_OUT, SRES_F32>(p, nullptr, ssm, sres, pbias);
    else if (sub == 1) { EpiUp E{p.ACT, ssm}; run_gemm(lds, p.X, 1024, p.wt_up + (size_t)layer * 4096 * 1024, 1024, 1024, 16, 0, 0, E);
        int rank, count; idle_rank(68 * 16, rank, count);
        if (rank >= 0) { if (layer == 0) wt_tiles<2>(p, rank, count); else if (layer == 1) wt_tiles<3>(p, rank, count); else if (layer == 2) wt_tiles<4>(p, rank, count); else cache_copy(p, rank, count); } }
    else { EpiResid<false> E{nullptr, nullptr, p.X, p.X, nullptr, slab, layer < 3 ? p.SSP : nullptr}; run_gemm(lds, p.ACT, 4096, p.wt_down + (size_t)layer * 1024 * 4096, 4096, 4096, 4, 0, SPLIT_DOWN, E); }
}

__device__ __forceinline__ void run_phase(const Params& p, int ph, LAS unsigned char* lds) {
    float* slab = (float*)(p.MLS + ML_DC);
    switch (ph) {
    case 0: wt_tiles<0>(p, (int)blockIdx.x, (int)gridDim.x); norm_phase<0, 0, false>(p, nullptr, p.SS, nullptr, nullptr); break;
    case 1: case 27: { const int j = ph == 1 ? 0 : 1;
        EpiMlstmIn E{p.ACT, (u16*)(p.MLS + ML_KT), (u16*)((unsigned char*)p.ACT + ACT_VT_OFF), (float*)(p.MLS + ML_G), p.SS + (size_t)(j == 0 ? 0 : 6) * MT};
        run_gemm(lds, p.X, 1024, p.wt_min + (size_t)j * 3328 * 1024, 1024, 1024, 13, 0, 0, E);
        if (j == 0) { int rank, count; idle_rank(68 * 13, rank, count); if (rank >= 0) { wt_tiles<1>(p, rank, count); misc_prep(p, rank, count); } } } break;
    case 2: case 28: { const int j = ph == 2 ? 0 : 1; mlstm_s1(p, j); mlstm_sample(p, j, lds); } break;
    case 3: case 29: mlstm_s2(p, ph == 3 ? 0 : 1, lds); break;
    case 4: case 30: mlstm_s3(p, ph == 4 ? 0 : 1, lds); break;
    case 5: case 31: { const int j = ph == 5 ? 0 : 1;
        if (j == 0) { EpiResid<true> E{p.xp, p.xs, nullptr, p.X, nullptr, slab, p.SSP}; run_gemm(lds, p.XN, 1024, p.wt_mout, 1024, 1024, 4, 0, SPLIT_OUT, E); }
        else { EpiResid<false> E{nullptr, nullptr, p.X, p.X, nullptr, slab, p.SSP}; run_gemm(lds, p.XN, 1024, p.wt_mout + (size_t)1024 * 1024, 1024, 1024, 4, 0, SPLIT_OUT, E); } } break;
    case 6: mlp_phases<true>(p, lds, 0, 0, p.xs, nullptr); break;
    case 7: case 8: mlp_phases<false>(p, lds, 0, ph - 6, nullptr, nullptr); break;
    case 9: norm_phase<1, SPLIT_DOWN, false>(p, nullptr, p.SS + (size_t)2 * MT, nullptr, nullptr); break;
    case 10: { EpiSwaQkv E{p.ACT, (u16*)(p.MLS + SW_VTP), p.KS, p.VTS, p.b_qkv, p.rope, p.out, p.SS + (size_t)2 * MT};
        run_gemm(lds, p.X, 1024, p.wt_qkv, 1024, 1024, 6, 0, 0, E); } break;
    case 11: attn_phase(p, lds); break;
    case 12: { EpiResid<false> E{nullptr, nullptr, p.X, p.X, p.b_sout, slab, p.SSP}; run_gemm(lds, p.XN, 1024, p.wt_sout, 1024, 1024, 4, 0, SPLIT_OUT, E); } break;
    case 13: mlp_phases<false>(p, lds, 1, 0, nullptr, p.b_sout); break;
    case 14: case 15: mlp_phases<false>(p, lds, 1, ph - 13, nullptr, nullptr); break;
    case 16: norm_phase<1, SPLIT_DOWN, false>(p, nullptr, p.SS + (size_t)4 * MT, nullptr, nullptr); break;
    case 17: { EpiRgIn E{(u16*)(p.MLS + RG_XB), (u16*)(p.MLS + RG_GG), p.out, p.SS + (size_t)4 * MT}; run_gemm(lds, p.X, 1024, p.wt_rgin, 1024, 1024, 8, 0, 0, E); } break;
    case 18: rg_conv_phase(p); break;
    case 19: { EpiRgGate E{(const u16*)(p.MLS + RG_U), p.ACT, p.ACT + (size_t)MT * 1024, p.b_a, p.b_x, p.lam};
        run_gemm(lds, (const u16*)(p.MLS + RG_U), 1024, p.wt_gate, 256, 256, 8, 512, 0, E); } break;
    case 20: rg_scan1(p); break;
    case 21: rg_scan2(p); break;
    case 22: { EpiResid<false> E{nullptr, nullptr, p.X, p.X, nullptr, slab, p.SSP}; run_gemm(lds, p.XN, 1024, p.wt_rgout, 1024, 1024, 4, 0, SPLIT_OUT, E); } break;
    case 23: mlp_phases<false>(p, lds, 2, 0, nullptr, nullptr); break;
    case 24: case 25: mlp_phases<false>(p, lds, 2, ph - 23, nullptr, nullptr); break;
    case 26: norm_phase<1, SPLIT_DOWN, false>(p, nullptr, p.SS + (size_t)6 * MT, nullptr, nullptr); break;
    case 32: mlp_phases<false>(p, lds, 3, 0, nullptr, nullptr); break;
    case 33: case 34: mlp_phases<false>(p, lds, 3, ph - 32, nullptr, nullptr); break;
    case 35: norm_phase<2, SPLIT_DOWN, false>(p, p.norm_final, nullptr, nullptr, nullptr); break;
    default: break;
    }
}

#define PROG_LIST {0,1,2,3,4,5,6,7,8,9,10,11,12,13,14,15,16,17,18,19,20,21,22,23,24,25,26,27,28,29,30,31,32,33,34,35}
constexpr int PROG[] = PROG_LIST;
constexpr int NSTEP = sizeof(PROG) / sizeof(int);
template <int I>
__device__ __forceinline__ void phase_step(const Params& p, LAS unsigned char* lds, const XcdBarrier& xb) {
    if (I >= p.p0 && I < p.p1) {
        if (I > p.p0) {
            if (I == p.p0 + 1 && p.p0 != 0) cg::this_grid().sync();
            else xcd_barrier(xb);
        }
        run_phase(p, PROG[I], lds);
    }
}
template <int... I>
__device__ __forceinline__ void run_all(const Params& p, LAS unsigned char* lds, const XcdBarrier& xb, std::integer_sequence<int, I...>) { (phase_step<I>(p, lds, xb), ...); }

constexpr int LDS_BYTES = pg8::STAGE_BYTES + 64;

__global__ void __launch_bounds__(512, 2) mk_fwd(Params p) {
    extern __shared__ __attribute__((aligned(16))) unsigned char shm[];
    LAS unsigned char* lds = (LAS unsigned char*)shm;
    volatile LAS unsigned* st = (volatile LAS unsigned*)(lds + pg8::STAGE_BYTES);
    const bool multi = (p.p1 - p.p0) > 1;
    XcdBarrier xb;
    if (multi) {
        if (threadIdx.x < 4) st[threadIdx.x] = 0u;
        __syncthreads();
        xb = xcd_barrier_post(p.bar, st);
    }
    run_all(p, lds, xb, std::make_integer_sequence<int, NSTEP>{});
}

static size_t align_up(size_t x, size_t a) { return (x + a - 1) / a * a; }

extern "C" void kernel_launch(void* const* d_in, const int* in_sizes, int n_in, void* d_out, int out_size, void* d_ws, size_t ws_size, hipStream_t stream) {
    static int grid = 0;
    if (grid == 0) {
        int dev = 0, cus = 0, per_cu = 0;
        (void)hipGetDevice(&dev);
        (void)hipDeviceGetAttribute(&cus, hipDeviceAttributeMultiprocessorCount, dev);
        if (hipFuncSetAttribute((const void*)mk_fwd, hipFuncAttributeMaxDynamicSharedMemorySize, LDS_BYTES) != hipSuccess) { fprintf(stderr, "hipFuncSetAttribute failed\n"); grid = -1; return; }
        (void)hipOccupancyMaxActiveBlocksPerMultiprocessor(&per_cu, (const void*)mk_fwd, 512, LDS_BYTES);
        (void)hipGetLastError();
        if (per_cu < 1) per_cu = 1;
        grid = cus * 1;
        if (n_in != 33 || out_size != (int)O_END) fprintf(stderr, "kernel_launch: unexpected n_in %d out_size %d\n", n_in, out_size);
    }
    if (grid < 0) return;
    Params p{};
    auto F = [&](int i) { return (const float*)d_in[i]; };
    p.xp = F(0); p.xs = F(1); p.st_c = F(2); p.st_n = F(3); p.st_m = F(4); p.ck = F(5); p.cv = F(6); p.st_h = F(7); p.st_conv = F(8);
    p.norm_mix = F(9); p.norm_mlp = F(10); p.norm_final = F(11);
    p.b_mi = F(15); p.b_mf = F(16); p.g_head = F(17); p.b_qkv = F(20); p.sinks = F(21); p.b_sout = F(23);
    p.w_conv = F(25); p.b_conv = F(26); p.b_a = F(28); p.b_x = F(30); p.lam = F(31);
    p.out = (float*)d_out;
    unsigned char* ws = (unsigned char*)d_ws; size_t off = 0;
    auto take = [&](size_t bytes) { unsigned char* r = ws + off; off = align_up(off + bytes, 256); return r; };
    p.bar = (unsigned*)take(XCD_BAR_WORDS * 4);
    p.SS = (float*)take((size_t)8 * MT * 4);
    p.SSP = (float*)take((size_t)MT * 16 * 4);
    p.rope = (f32x2*)take((size_t)8200 * 8 * 8);
    p.wt_up = (u16*)take((size_t)4 * 4096 * 1024 * 2);
    p.wt_down = (u16*)take((size_t)4 * 1024 * 4096 * 2);
    p.wt_min = (u16*)take((size_t)2 * 3328 * 1024 * 2);
    p.wt_mout = (u16*)take((size_t)2 * 1024 * 1024 * 2);
    p.wt_qkv = (u16*)take((size_t)1536 * 1024 * 2);
    p.wt_sout = (u16*)take((size_t)1024 * 1024 * 2);
    p.wt_rgin = (u16*)take((size_t)2048 * 1024 * 2);
    p.wt_rgout = (u16*)take((size_t)1024 * 1024 * 2);
    p.wt_gate = (u16*)take((size_t)2048 * 256 * 2);
    p.X = (u16*)take((size_t)MT * DM * 2);
    p.XN = (u16*)take((size_t)MT * DM * 2);
    p.ACT = (u16*)take(ACT_BYTES);
    p.MLS = take(ML_END);
    p.KS = (u16*)take((size_t)128 * 4 * 160 * 64 * 2);
    p.VTS = (u16*)take((size_t)128 * 4 * 160 * 64 * 2);
    if (off > ws_size) { fprintf(stderr, "kernel_launch: workspace too small: need %zu have %zu\n", off, ws_size); return; }
    p.w_up = F(12); p.w_down = F(13); p.w_min = F(14); p.w_mout = F(18); p.w_qkv = F(19); p.w_sout = F(22); p.w_rgin = F(24); p.w_rgout = F(32); p.w_a = F(27); p.w_x = F(29);
    (void)hipMemsetAsync(p.bar, 0, XCD_BAR_WORDS * 4, stream);
#if SINGLE_LAUNCH
    p.p0 = 0; p.p1 = NSTEP;
    void* args[] = {&p};
    hipError_t e = hipLaunchCooperativeKernel((const void*)mk_fwd, dim3(grid), dim3(512), args, LDS_BYTES, stream);
    if (e != hipSuccess) fprintf(stderr, "cooperative launch failed: %s (grid %d)\n", hipGetErrorString(e), grid);
#else
    for (int ph = 0; ph < NSTEP; ++ph) {
        p.p0 = ph; p.p1 = ph + 1;
        hipLaunchKernelGGL(mk_fwd, dim3(grid), dim3(512), LDS_BYTES, stream, p);
    }
#endif
}
```
